# Optimizing an MI355X kernel written in HIP

```python
import jax, jax.numpy as jnp
from jax import lax
import numpy as np

D_MODEL = 2048
BATCH = 1
SEQ = 8192
DEPTH = 2

CTX_LEN = 256
GRID_W = 64
D_MIX = D_MODEL
D_CONV = D_MIX // 2
D_RET = D_MIX - D_CONV
RET_HEADS = 8
RET_HEAD_DIM = D_RET // RET_HEADS
CONV_WIDTH = 3
CHUNK = 128
D_IN = 4 * D_CONV + 4 * D_RET
ROPE_BASE = 10000.0
RET_DECAY_OFFSET = 5.0
EPS = 1e-6

kernel_name = "hybrid_conv_retention_prefix_dit_block"


def _rmsnorm(x, w):
    xf = x.astype(jnp.float32)
    y = xf * lax.rsqrt(jnp.mean(xf * xf, axis=-1, keepdims=True) + EPS)
    return (y * w.astype(jnp.float32)).astype(x.dtype)


def _split_in(u):
    idx = [D_CONV, 2 * D_CONV, 3 * D_CONV, 4 * D_CONV,
           4 * D_CONV + D_RET, 4 * D_CONV + 2 * D_RET, 4 * D_CONV + 3 * D_RET]
    return jnp.split(u, idx, axis=-1)


def _short_conv(u, w):
    up = jnp.pad(u, ((0, 0), (1, 1), (0, 0)))
    return up[:, :-2] * w[0] + up[:, 1:-1] * w[1] + up[:, 2:] * w[2]


def _conv_branch(h, b, c, z, conv_w, norm_w):
    y = b * _short_conv(c * h, conv_w)
    return jax.nn.silu(z) * _rmsnorm(y, norm_w)


def _heads(t):
    b, l, _ = t.shape
    return t.reshape(b, l, RET_HEADS, RET_HEAD_DIM).transpose(0, 2, 1, 3)


def _rope_1d(x, pos):
    f = x.shape[-1] // 2
    inv = ROPE_BASE ** (-jnp.arange(f, dtype=jnp.float32) / f)
    ang = pos.astype(jnp.float32)[:, None] * inv[None, :]
    cos, sin = jnp.cos(ang), jnp.sin(ang)
    x1, x2 = x[..., :f], x[..., f:]
    return jnp.concatenate([x1 * cos - x2 * sin, x1 * sin + x2 * cos], axis=-1).astype(x.dtype)


def _axial_rope(x, row_pos, col_pos):
    half = x.shape[-1] // 2
    return jnp.concatenate([_rope_1d(x[..., :half], row_pos),
                            _rope_1d(x[..., half:], col_pos)], axis=-1)


def _chunk_retention(q, k, v, lg, s0):
    b, h, l, dk = q.shape
    n = l // CHUNK
    qc = q.reshape(b, h, n, CHUNK, dk)
    kc = k.reshape(b, h, n, CHUNK, dk)
    vc = v.reshape(b, h, n, CHUNK, v.shape[-1])
    pos = jnp.arange(CHUNK, dtype=jnp.float32)
    diff = pos[:, None] - pos[None, :]
    dmask = jnp.where(diff >= 0, jnp.exp(lg[:, None, None] * jnp.maximum(diff, 0.0)[None]), 0.0)
    scores = jnp.einsum('bhnid,bhnjd->bhnij', qc, kc) * dmask[None, :, None]
    intra = jnp.einsum('bhnij,bhnje->bhnie', scores, vc)
    k_decay = jnp.exp(lg[:, None] * (CHUNK - 1 - pos)[None])
    q_decay = jnp.exp(lg[:, None] * (pos + 1.0)[None])
    chunk_decay = jnp.exp(lg * CHUNK)
    chunk_kv = jnp.einsum('bhnjd,hj,bhnje->nbhde', kc, k_decay, vc)

    def step(s, kv):
        return chunk_decay[None, :, None, None] * s + kv, s

    _, s_prev = lax.scan(step, s0, chunk_kv)
    inter = jnp.einsum('bhnid,hi,nbhde->bhnie', qc, q_decay, s_prev)
    return (intra + inter).reshape(b, h, l, -1)


def _bidir_retention(q, k, v, lg_f, lg_b, s0_f, s0_b):
    o_f = _chunk_retention(q, k, v, lg_f, s0_f)
    flip = lambda t: jnp.flip(t, axis=2)
    o_b = _chunk_retention(flip(q), flip(k), flip(v), lg_b, s0_b)
    return o_f + flip(o_b)


def _context_states(k, v, lg_f, lg_b):
    lc = k.shape[2]
    t = jnp.arange(lc, dtype=jnp.float32)
    w_f = jnp.exp(lg_f[:, None] * (lc - 1.0 - t)[None])
    w_b = jnp.exp(lg_b[:, None] * t[None])
    s_f = jnp.einsum('bhtd,ht,bhte->bhde', k, w_f, v)
    s_b = jnp.einsum('bhtd,ht,bhte->bhde', k, w_b, v)
    return s_f, s_b


def _ret_out(o, z, gn_w):
    of = o.astype(jnp.float32)
    mu = jnp.mean(of, axis=-1, keepdims=True)
    var = jnp.mean(jnp.square(of - mu), axis=-1, keepdims=True)
    on = (of - mu) * lax.rsqrt(var + EPS)
    b, h, l, d = on.shape
    on = on.transpose(0, 2, 1, 3).reshape(b, l, h * d) * gn_w.astype(jnp.float32)
    return jax.nn.silu(z) * on.astype(z.dtype)


def _layer(x, ctx, c, c_ctx, norm_w, w_mod, b_mod, w_in, conv_w, conv_norm_w, ret_norm_w,
           decay_f, decay_b, w_out, row_pos, col_pos, update_ctx):
    d = D_MODEL
    lg_f = -jnp.exp(decay_f.astype(jnp.float32))
    lg_b = -jnp.exp(decay_b.astype(jnp.float32))
    k_scale = RET_HEAD_DIM ** -0.5

    shift, scale, gate = jnp.split(jax.nn.silu(c) @ w_mod + b_mod, 3, axis=-1)
    hx = _rmsnorm(x, norm_w) * (1 + scale[:, None]) + shift[:, None]
    a_h, a_b, a_c, a_z, q, k, v, r_z = _split_in(hx @ w_in)

    n_mod = 3 if update_ctx else 2
    mod_c = jax.nn.silu(c_ctx) @ w_mod[:, :n_mod * d] + b_mod[:n_mod * d]
    hc = _rmsnorm(ctx, norm_w) * (1 + mod_c[d:2 * d]) + mod_c[:d]
    if update_ctx:
        ca_h, ca_b, ca_c, ca_z, cq, ck, cv, cr_z = _split_in(hc @ w_in)
    else:
        kv0 = 4 * D_CONV + D_RET
        ck, cv = jnp.split(hc @ w_in[:, kv0:kv0 + 2 * D_RET], 2, axis=-1)
    ck_h = _heads(ck) * k_scale
    cv_h = _heads(cv)
    s_f, s_b = _context_states(ck_h, cv_h, lg_f, lg_b)

    q_h = _axial_rope(_heads(q), row_pos, col_pos)
    k_h = _axial_rope(_heads(k), row_pos, col_pos) * k_scale
    o = _bidir_retention(q_h, k_h, _heads(v), lg_f, lg_b, s_f, s_b)
    y_ret = _ret_out(o, r_z, ret_norm_w)
    y_conv = _conv_branch(a_h, a_b, a_c, a_z, conv_w, conv_norm_w)
    x = x + gate[:, None] * (jnp.concatenate([y_conv, y_ret], axis=-1) @ w_out)

    if update_ctx:
        zeros = jnp.zeros_like(s_f)
        oc = _bidir_retention(_heads(cq), ck_h, cv_h, lg_f, lg_b, zeros, zeros)
        yc_ret = _ret_out(oc, cr_z, ret_norm_w)
        yc_conv = _conv_branch(ca_h, ca_b, ca_c, ca_z, conv_w, conv_norm_w)
        ctx = ctx + mod_c[2 * d:] * (jnp.concatenate([yc_conv, yc_ret], axis=-1) @ w_out)
    return x, ctx


def setup_inputs(seed: int = 0) -> dict:
    key = jax.random.key(seed)
    ks = jax.random.split(key, 16)
    f32 = jnp.float32
    nrm = lambda k, s: jax.random.normal(k, s, f32)
    base = jnp.log(-jnp.log1p(-(2.0 ** -(RET_DECAY_OFFSET + jnp.arange(RET_HEADS, dtype=f32)))))
    return {
        "x": nrm(ks[0], (BATCH, SEQ, D_MODEL)),
        "c": nrm(ks[1], (BATCH, D_MODEL)),
        "ctx": nrm(ks[2], (BATCH, CTX_LEN, D_MODEL)),
        "c_ctx": nrm(ks[3], (D_MODEL,)),
        "norm_w": 1.0 + 0.05 * nrm(ks[4], (DEPTH, D_MODEL)),
        "w_mod": nrm(ks[5], (DEPTH, D_MODEL, 3 * D_MODEL)) * (0.5 * D_MODEL ** -0.5),
        "b_mod": 0.02 * nrm(ks[6], (DEPTH, 3 * D_MODEL)),
        "w_in": nrm(ks[7], (DEPTH, D_MODEL, D_IN)) * D_MODEL ** -0.5,
        "conv_w": nrm(ks[8], (DEPTH, CONV_WIDTH, D_CONV)) * CONV_WIDTH ** -0.5,
        "conv_norm_w": 1.0 + 0.05 * nrm(ks[9], (DEPTH, D_CONV)),
        "ret_norm_w": 1.0 + 0.05 * nrm(ks[10], (DEPTH, D_RET)),
        "ret_decay_f": base[None] + 0.05 * nrm(ks[11], (DEPTH, RET_HEADS)),
        "ret_decay_b": base[None] + 0.05 * nrm(ks[12], (DEPTH, RET_HEADS)),
        "w_out": nrm(ks[13], (DEPTH, D_MIX, D_MODEL)) * D_MIX ** -0.5,
        "final_norm_w": 1.0 + 0.05 * nrm(ks[14], (D_MODEL,)),
    }


def reference(x, c, ctx, c_ctx, norm_w, w_mod, b_mod, w_in, conv_w, conv_norm_w, ret_norm_w,
              ret_decay_f, ret_decay_b, w_out, final_norm_w):
    seq = x.shape[1]
    rows = seq // GRID_W
    row_pos = jnp.repeat(jnp.arange(rows), GRID_W)
    col_pos = jnp.tile(jnp.arange(GRID_W), rows)
    for layer in range(DEPTH):
        x, ctx = _layer(x, ctx, c, c_ctx, norm_w[layer], w_mod[layer], b_mod[layer], w_in[layer],
                        conv_w[layer], conv_norm_w[layer], ret_norm_w[layer],
                        ret_decay_f[layer], ret_decay_b[layer], w_out[layer],
                        row_pos, col_pos, layer < DEPTH - 1)
    return _rmsnorm(x, final_norm_w)
```

```cpp
#include <hip/hip_runtime.h>
#include <hip/hip_cooperative_groups.h>
#include <cstdio>
#include <cstdint>
namespace cg = cooperative_groups;
namespace pg8 {
#define PG8_LAS __attribute__((address_space(3)))
typedef unsigned short bf16_t;
typedef short bf16x8 __attribute__((ext_vector_type(8)));
typedef float f32x4 __attribute__((ext_vector_type(4)));
typedef unsigned u32x4 __attribute__((ext_vector_type(4)));
constexpr int BM = 256, BK = 64, HALF = 128, HTB = HALF * BK * 2  , STAGE_BYTES = 8 * HTB, NXCD = 8, WGM = 8;

__host__ __device__ __forceinline__ int lds_byte(int r, int c) { const int st = (r >> 4) * 2 + (c >> 5), rr = r & 15, cc = c & 31, ob = rr * 64 + cc * 2; return st * 1024 + (ob ^ (((ob >> 9) & 1) << 5)); }
__host__ __device__ __forceinline__ void stage_rc(int b, int& R, int& C) { const int st = b / 1024, sb = b % 1024, swz = sb ^ (((sb >> 9) & 1) << 5); R = (st >> 1) * 16 + swz / 64; C = (st & 1) * 32 + (swz % 64) / 2; }
__host__ __device__ __forceinline__ int perm32(int rho) { const int n = rho >> 4, i = rho & 15; return 8 * (i >> 2) + 4 * n + (i & 3); }

struct Unit { int pm, pn; };
struct Gemm { const bf16_t* A; const bf16_t* Bt; int M, N, K; };

struct StaticOrder {
    int nM, nN, nwg, G, c;
    __host__ __device__ void init(int M, int N, int G_, int c_) { nM = M / BM; nN = N / BM; nwg = nM * nN; G = G_; c = c_; }
    __host__ __device__ bool next(int i, Unit& u) const {
        const long L = (long)i * G + c; if (L >= nwg) return false;
        int wgid = (int)L; { const int q = nwg / NXCD, r = nwg % NXCD, xcd = wgid % NXCD, off = wgid / NXCD; wgid = (xcd < r ? xcd * (q + 1) : r * (q + 1) + (xcd - r) * q) + off; }
        const int nig = WGM * nN, gid = wgid / nig, fm = gid * WGM, gsz = (nM - fm) < WGM ? (nM - fm) : WGM;
        u.pm = fm + ((wgid % nig) % gsz); u.pn = (wgid % nig) / gsz; return true;
    }
    __device__ __forceinline__ void a_ready(const Unit&) const {}
    __device__ __forceinline__ void done(const Unit&) const {}
};
__device__ __forceinline__ unsigned cvt_pk_bf16(float lo, float hi) { unsigned r; asm volatile("v_cvt_pk_bf16_f32 %0, %1, %2" : "=v"(r) : "v"(lo), "v"(hi)); return r; }
struct EpiIn {
    static constexpr bool PERM = true, AFTER_DRAIN = false;
    bf16_t* U; const float* rope;
    const float* cw; const float* cnw; bf16_t* CAT; float* rowsq;
    __device__ __forceinline__ void operator()(const f32x4 (&acc)[2][2][4][2], const Unit& u, int wr, int wc, int fr, int fq) const {
        const int row0 = u.pm * BM + wr * 64 + fr;
        const int col0 = u.pn * BM + wc * 32 + 8 * fq;
        if (u.pn < 16) {
            const int ch0 = u.pn * 64 + wc * 16 + fq * 4, lane = 16 * fq + fr;
            const f32x4 w0 = *(const f32x4*)(cw + ch0), w1 = *(const f32x4*)(cw + 1024 + ch0), w2 = *(const f32x4*)(cw + 2048 + ch0), nw = *(const f32x4*)(cnw + ch0);
#pragma unroll
            for (int ai = 0; ai < 2; ++ai) {
                f32x4 g[4];
#pragma unroll
                for (int m = 0; m < 4; ++m) g[m] = acc[ai][0][m][0] * acc[ai][0][m][1];
#pragma unroll
                for (int m = 0; m < 4; ++m) {
                    f32x4 gp, gn;
#pragma unroll
                    for (int j = 0; j < 4; ++j) {
                        const float a = __shfl(g[m][j], lane - 1), aw = (m > 0) ? __shfl(g[m > 0 ? m - 1 : 0][j], lane + 15) : 0.f;
                        const float c = __shfl(g[m][j], lane + 1), cw_ = (m < 3) ? __shfl(g[m < 3 ? m + 1 : 3][j], lane - 15) : 0.f;
                        gp[j] = fr > 0 ? a : aw; gn[j] = fr < 15 ? c : cw_; }
                    const bool valid = !((m == 0 && fr == 0) || (m == 3 && fr == 15));
                    const bool edge = (m == 0 && fr < 2) || (m == 3 && fr >= 14);
                    const int row = row0 + ai * HALF + m * 16;
                    const f32x4 bq = acc[ai][1][m][0], zq = acc[ai][1][m][1];
                    const f32x4 y = bq * (w0 * gp + w1 * g[m] + w2 * gn);
                    float ss = (y[0] * y[0] + y[1] * y[1]) + (y[2] * y[2] + y[3] * y[3]);
                    ss += __shfl_xor(ss, 16); ss += __shfl_xor(ss, 32);
                    if (valid) {
                        if (fq == 0) atomicAdd(rowsq + row, ss);
                        f32x4 o;
#pragma unroll
                        for (int j = 0; j < 4; ++j) o[j] = zq[j] * __builtin_amdgcn_rcpf(1.f + __builtin_amdgcn_exp2f(-1.4426950408889634f * zq[j])) * y[j] * nw[j];
                        unsigned lo = cvt_pk_bf16(o[0], o[1]), hi = cvt_pk_bf16(o[2], o[3]);
                        unsigned long long w = (unsigned long long)lo | ((unsigned long long)hi << 32);
                        *(unsigned long long*)(CAT + (size_t)row * 2048 + ch0) = w; }
                    if (edge) {
                        bf16_t* rowp = U + (size_t)row * 8192 + col0;
#pragma unroll
                        for (int bj = 0; bj < 2; ++bj) { const f32x4 v0 = acc[ai][bj][m][0] * 1.f, v1 = acc[ai][bj][m][1] * 1.f;
                            u32x4 w; w.x = cvt_pk_bf16(v0[0], v0[1]); w.y = cvt_pk_bf16(v0[2], v0[3]); w.z = cvt_pk_bf16(v1[0], v1[1]); w.w = cvt_pk_bf16(v1[2], v1[3]);
                            *(u32x4*)(rowp + bj * HALF) = w; } }
                }
            }
            return;
        }
        const int kind = u.pn >> 2;
        const float sc = (kind == 5) ? 0.08838834764831845f : 1.f;
        const bool dorope = (kind == 4 || kind == 5) && (u.pm < 32);
        const int fi = (wc & 1) * 16 + fq * 4;
#pragma unroll
        for (int ai = 0; ai < 2; ++ai)
#pragma unroll
            for (int m = 0; m < 4; ++m) {
                const int row = row0 + ai * HALF + m * 16;
                bf16_t* rowp = U + (size_t)row * 8192 + col0;
                f32x4 cs = (f32x4){1.f, 1.f, 1.f, 1.f}, sn = (f32x4){0.f, 0.f, 0.f, 0.f};
                if (dorope) { const int pos = (wc < 2) ? (row >> 6) : (row & 63); cs = *(const f32x4*)(rope + pos * 32 + fi); sn = *(const f32x4*)(rope + 4096 + pos * 32 + fi); }
#pragma unroll
                for (int bj = 0; bj < 2; ++bj) {
                    f32x4 v0 = acc[ai][bj][m][0], v1 = acc[ai][bj][m][1];
                    const f32x4 a = (v0 * cs - v1 * sn) * sc, b = (v0 * sn + v1 * cs) * sc;
                    u32x4 w; w.x = cvt_pk_bf16(a[0], a[1]); w.y = cvt_pk_bf16(a[2], a[3]); w.z = cvt_pk_bf16(b[0], b[1]); w.w = cvt_pk_bf16(b[2], b[3]);
                    *(u32x4*)(rowp + bj * HALF) = w; }
            }
    }
};
struct EpiRes {
    static constexpr bool PERM = false, AFTER_DRAIN = false;
    const float* rx; const float* rc; float* out; const float* gx; const float* gc;
    __device__ __forceinline__ void operator()(const f32x4 (&acc)[2][2][4][2], const Unit& u, int wr, int wc, int fr, int fq) const {
        const int row0 = u.pm * BM + wr * 64 + fr, col0 = u.pn * BM + wc * 32 + 4 * fq;
        const bool isctx = u.pm >= 32;
        const float* g = isctx ? gc : gx;
        f32x4 gv[2][2];
#pragma unroll
        for (int bj = 0; bj < 2; ++bj)
#pragma unroll
            for (int n = 0; n < 2; ++n) gv[bj][n] = *(const f32x4*)(g + col0 + bj * HALF + n * 16);
        f32x4 r[2][2][2][2];
#define ER_LOAD(buf, b) do { const int ai_ = (b) >> 1, mp_ = ((b) & 1) * 2; _Pragma("unroll") for (int mm = 0; mm < 2; ++mm) { const int row = row0 + ai_ * HALF + (mp_ + mm) * 16; \
            const float* rp = (isctx ? rc + (size_t)(row - 8192) * 2048 : rx + (size_t)row * 2048) + col0; \
            _Pragma("unroll") for (int bj = 0; bj < 2; ++bj) _Pragma("unroll") for (int n = 0; n < 2; ++n) r[buf][mm][bj][n] = __builtin_nontemporal_load((const f32x4*)(rp + bj * HALF + n * 16)); } } while (0)
        ER_LOAD(0, 0);
#pragma unroll
        for (int b = 0; b < 4; ++b) {
            if (b + 1 < 4) { if (b & 1) ER_LOAD(0, b + 1); else ER_LOAD(1, b + 1); }
            __builtin_amdgcn_sched_barrier(0);
            const int ai = b >> 1, mp = (b & 1) * 2;
#pragma unroll
            for (int mm = 0; mm < 2; ++mm) {
                const int row = row0 + ai * HALF + (mp + mm) * 16;
                float* op = out + (size_t)row * 2048 + col0;
#pragma unroll
                for (int bj = 0; bj < 2; ++bj)
#pragma unroll
                    for (int n = 0; n < 2; ++n) *(f32x4*)(op + bj * HALF + n * 16) = r[b & 1][mm][bj][n] + gv[bj][n] * acc[ai][bj][mp + mm][n];
            }
            __builtin_amdgcn_sched_barrier(0);
        }
#undef ER_LOAD
    }
};
template <class Epi, class Sched, bool ALIGN_EPI = false, bool SP2 = false>
__device__ __forceinline__ void gemm_phase(PG8_LAS unsigned char* lds, const Gemm g, const Sched& S, const Epi& E) {
    int tid_ = threadIdx.x; asm volatile("" : "+v"(tid_));
    const int tid = tid_, wid = __builtin_amdgcn_readfirstlane(tid >> 6), lane = tid & 63, wr = wid >> 2, wc = wid & 3, fr = lane & 15, fq = lane >> 4;
    const int K = g.K, nt = K / BK;
    unsigned voffA[2], voffB[2];
#pragma unroll
    for (int i = 0; i < 2; ++i) { int R, C; stage_rc(tid * 16 + i * 8192, R, C); const int Rb = Epi::PERM ? ((R & ~31) + perm32(R & 31)) : R;
        voffA[i] = (unsigned)(R * K + C) * 2u; voffB[i] = (unsigned)(Rb * K + C) * 2u; }
    const size_t kstep = (size_t)(BK * 2);
    const size_t hstep = (size_t)HALF * K * 2;
    const size_t tstep = 2 * hstep;
    const unsigned ldsw = (unsigned)wid * 1024u;
    const int aoff = lds_byte(wr * 64 + fr, fq * 8), boff = lds_byte(wc * 32 + fr, fq * 8);
#define PG8_SA(b, h) (((b) * 2 + (h)) * HTB)
#define PG8_SB(b, h) ((4 + (b) * 2 + (h)) * HTB)
#define PG8_STAGE(bufoff, gbase, voff) do { _Pragma("unroll") for (int _i = 0; _i < 2; ++_i) \
        __builtin_amdgcn_global_load_lds((const unsigned*)((const char*)(gbase) + (voff)[_i]), (PG8_LAS unsigned*)(lds + (bufoff) + ldsw + _i * 8192), 16, 0, 0); } while (0)
#define PG8_LDA(dst, b, h) do { _Pragma("unroll") for (int m = 0; m < 4; ++m) _Pragma("unroll") for (int k = 0; k < 2; ++k) dst[m][k] = *(const PG8_LAS bf16x8*)(lds + PG8_SA(b, h) + aoff + m * 2048 + k * 1024); } while (0)
#define PG8_LDB(dst, b, h) do { _Pragma("unroll") for (int n = 0; n < 2; ++n) _Pragma("unroll") for (int k = 0; k < 2; ++k) dst[n][k] = *(const PG8_LAS bf16x8*)(lds + PG8_SB(b, h) + boff + n * 2048 + k * 1024); } while (0)
#define PG8_MMA(ai, bj, At, Bt) do { __builtin_amdgcn_s_setprio(1); _Pragma("unroll") for (int m = 0; m < 4; ++m) _Pragma("unroll") for (int n = 0; n < 2; ++n) _Pragma("unroll") for (int k = 0; k < 2; ++k) \
        acc[ai][bj][m][n] = __builtin_amdgcn_mfma_f32_16x16x32_bf16(Bt[n][k], At[m][k], acc[ai][bj][m][n], 0, 0, 0); __builtin_amdgcn_s_setprio(0); } while (0)
#define PG8_WAIT_V(n) asm volatile("s_waitcnt vmcnt(" #n ")" ::: "memory")
#define PG8_WAIT_L(n) asm volatile("s_waitcnt lgkmcnt(" #n ")" ::: "memory")
#define PG8_BAR __builtin_amdgcn_s_barrier()
#define PG8_SCHED __builtin_amdgcn_sched_barrier(0)
    Unit cur, nxt; int ui = 0;
    if (!S.next(0, cur)) return;
    f32x4 acc[2][2][4][2];
#pragma unroll
    for (int a = 0; a < 2; ++a)
#pragma unroll
        for (int b = 0; b < 2; ++b)
#pragma unroll
            for (int m = 0; m < 4; ++m)
#pragma unroll
                for (int n = 0; n < 2; ++n) acc[a][b][m][n] = (f32x4){0.f, 0.f, 0.f, 0.f};
    bf16x8 At[4][2], B0[2][2], B1[2][2];
    const char* cA = (const char*)g.A + (size_t)cur.pm * tstep; const char* cB = (const char*)g.Bt + (size_t)cur.pn * tstep;
    S.a_ready(cur);
    if constexpr (SP2) {
        PG8_STAGE(PG8_SB(0, 0), cB, voffB); PG8_STAGE(PG8_SB(0, 1), cB + hstep, voffB); PG8_STAGE(PG8_SA(0, 0), cA, voffA); PG8_STAGE(PG8_SA(0, 1), cA + hstep, voffA);
        if (wr == 1) PG8_BAR;
        PG8_WAIT_V(2); PG8_BAR;
        PG8_STAGE(PG8_SB(1, 0), cB + kstep, voffB); PG8_STAGE(PG8_SA(1, 0), cA + kstep, voffA); PG8_STAGE(PG8_SB(1, 1), cB + hstep + kstep, voffB);
        PG8_WAIT_V(6); PG8_BAR;
    } else {
        PG8_STAGE(PG8_SB(0, 0), cB, voffB); PG8_STAGE(PG8_SA(0, 0), cA, voffA); PG8_STAGE(PG8_SB(0, 1), cB + hstep, voffB); PG8_STAGE(PG8_SA(0, 1), cA + hstep, voffA);
        if (wr == 1) PG8_BAR;
        PG8_WAIT_V(4); PG8_BAR;
        PG8_STAGE(PG8_SB(1, 0), cB + kstep, voffB); PG8_STAGE(PG8_SA(1, 0), cA + kstep, voffA); PG8_STAGE(PG8_SB(1, 1), cB + hstep + kstep, voffB);
        PG8_WAIT_V(6); PG8_BAR;
    }
    for (;;) {
        const bool has_next = S.next(ui + 1, nxt);
        const char* nA = has_next ? (const char*)g.A + (size_t)nxt.pm * tstep : cA; const char* nB = has_next ? (const char*)g.Bt + (size_t)nxt.pn * tstep : cB;
        for (int t = 0; t < nt; t += 2) {
            const bool last = (t == nt - 2);
            const char* a1 = cA + (size_t)(t + 1) * kstep;
            const char* a2 = last ? nA : cA + (size_t)(t + 2) * kstep; const char* b2 = last ? nB : cB + (size_t)(t + 2) * kstep;
            const char* a3 = a2 + kstep; const char* b3 = b2 + kstep;
            if (last && has_next) S.a_ready(nxt);
            if constexpr (SP2) {
            PG8_LDB(B0, 0, 0); PG8_LDB(B1, 0, 1); PG8_SCHED; PG8_LDA(At, 0, 0); PG8_STAGE(PG8_SA(1, 1), a1 + hstep, voffA);
            PG8_WAIT_V(8); PG8_WAIT_L(0); PG8_BAR; PG8_MMA(0, 0, At, B0); PG8_MMA(0, 1, At, B1); PG8_BAR; PG8_SCHED;
            PG8_LDA(At, 0, 1); PG8_STAGE(PG8_SB(0, 0), b2, voffB); PG8_STAGE(PG8_SB(0, 1), b2 + hstep, voffB); PG8_STAGE(PG8_SA(0, 0), a2, voffA);
            PG8_WAIT_V(8); PG8_WAIT_L(0); PG8_BAR; PG8_MMA(1, 0, At, B0); PG8_MMA(1, 1, At, B1); PG8_BAR; PG8_SCHED;
            PG8_LDB(B0, 1, 0); PG8_LDB(B1, 1, 1); PG8_SCHED; PG8_LDA(At, 1, 0); PG8_STAGE(PG8_SA(0, 1), a2 + hstep, voffA);
            PG8_WAIT_V(8); PG8_WAIT_L(0); PG8_BAR; PG8_MMA(0, 0, At, B0); PG8_MMA(0, 1, At, B1); PG8_BAR; PG8_SCHED;
            PG8_LDA(At, 1, 1); PG8_STAGE(PG8_SB(1, 0), b3, voffB); PG8_STAGE(PG8_SB(1, 1), b3 + hstep, voffB); PG8_STAGE(PG8_SA(1, 0), a3, voffA);
            PG8_WAIT_V(8); PG8_WAIT_L(0); PG8_BAR; PG8_MMA(1, 0, At, B0); PG8_MMA(1, 1, At, B1); PG8_BAR; PG8_SCHED;
            } else {
            PG8_LDB(B0, 0, 0); PG8_SCHED; PG8_LDA(At, 0, 0); PG8_STAGE(PG8_SA(1, 1), a1 + hstep, voffA);
            PG8_WAIT_L(8); PG8_BAR; PG8_WAIT_L(0); PG8_MMA(0, 0, At, B0); PG8_BAR; PG8_SCHED;
            PG8_LDB(B1, 0, 1); PG8_STAGE(PG8_SB(0, 0), b2, voffB);
            PG8_BAR; PG8_WAIT_L(0); PG8_MMA(0, 1, At, B1); PG8_BAR;
            PG8_LDA(At, 0, 1); PG8_STAGE(PG8_SA(0, 0), a2, voffA);
            PG8_BAR; PG8_WAIT_L(0); PG8_MMA(1, 0, At, B0); PG8_BAR; PG8_SCHED;
            PG8_STAGE(PG8_SB(0, 1), b2 + hstep, voffB);
            PG8_WAIT_V(6); PG8_BAR; PG8_MMA(1, 1, At, B1); PG8_BAR;
            PG8_LDB(B0, 1, 0); PG8_SCHED; PG8_LDA(At, 1, 0); PG8_STAGE(PG8_SA(0, 1), a2 + hstep, voffA);
            PG8_WAIT_L(8); PG8_BAR; PG8_WAIT_L(0); PG8_MMA(0, 0, At, B0); PG8_BAR; PG8_SCHED;
            PG8_LDB(B1, 1, 1); PG8_STAGE(PG8_SB(1, 0), b3, voffB);
            PG8_BAR; PG8_WAIT_L(0); PG8_MMA(0, 1, At, B1); PG8_BAR;
            PG8_LDA(At, 1, 1); PG8_STAGE(PG8_SA(1, 0), a3, voffA);
            PG8_BAR; PG8_WAIT_L(0); PG8_MMA(1, 0, At, B0); PG8_BAR; PG8_SCHED;
            PG8_STAGE(PG8_SB(1, 1), b3 + hstep, voffB);
            PG8_WAIT_V(6); PG8_BAR; PG8_MMA(1, 1, At, B1); PG8_BAR;
            }
        }
        if constexpr (ALIGN_EPI) { if (wr == 0) PG8_BAR; }
        if constexpr (!Epi::AFTER_DRAIN) { E(acc, cur, wr, wc, fr, fq); S.done(cur); }
        if (!has_next) break;
#pragma unroll
        for (int a = 0; a < 2; ++a)
#pragma unroll
            for (int b = 0; b < 2; ++b)
#pragma unroll
                for (int m = 0; m < 4; ++m)
#pragma unroll
                    for (int n = 0; n < 2; ++n) acc[a][b][m][n] = (f32x4){0.f, 0.f, 0.f, 0.f};
        cur = nxt; cA = nA; cB = nB; ++ui;
        if constexpr (ALIGN_EPI) { if (wr == 1) PG8_BAR; }
    }
    PG8_WAIT_V(0);
    if constexpr (!ALIGN_EPI) { if (wr == 0) PG8_BAR; }
    PG8_BAR;
    if constexpr (Epi::AFTER_DRAIN) { E.fused(acc, cur, wr, wc, fr, fq, lds, wid, lane); S.done(cur); }
#undef PG8_SA
#undef PG8_SB
#undef PG8_STAGE
#undef PG8_LDA
#undef PG8_LDB
#undef PG8_MMA
#undef PG8_WAIT_V
#undef PG8_WAIT_L
#undef PG8_BAR
#undef PG8_SCHED
}
}

#ifndef PH
#define PH 255
#endif
#ifndef REP_B
#define REP_B 1
#endif
#ifndef REP_CDE
#define REP_CDE 1
#endif
#ifndef REP_T
#define REP_T 1
#endif
#ifndef REP_C
#define REP_C 1
#endif
#ifndef REP_D
#define REP_D 1
#endif
#ifndef REP_E
#define REP_E 1
#endif
#ifndef REP_A
#define REP_A 1
#endif
#ifndef REP_F0
#define REP_F0 1
#endif
#define LAS __attribute__((address_space(3)))
typedef unsigned short bf16_t;
typedef short bf16x8 __attribute__((ext_vector_type(8)));
typedef short s16x4 __attribute__((ext_vector_type(4)));
typedef float f32x4 __attribute__((ext_vector_type(4)));
typedef unsigned u32x4 __attribute__((ext_vector_type(4)));
typedef unsigned u32x2 __attribute__((ext_vector_type(2)));

constexpr int D = 2048, SEQ = 8192, CTXL = 256, MROWS = SEQ + CTXL, DIN = 8192, DCONV = 1024, NH = 8, DH = 128, NCH = MROWS / 128  ;
constexpr float EPS = 1e-6f;
constexpr float LOG2E = 1.4426950408889634f;
constexpr int NTHREADS = 512, NWAVES = 8;
constexpr int L1C_A = 1920, L1C_B = 6792, L1C_C = 8192, L1C_D = 9216;
constexpr int LDS_BYTES = 147456;

constexpr size_t MiB = 1u << 20;
constexpr size_t WS_CTL = 0, CTL_ZERO_BYTES = 1 * MiB;
constexpr size_t WS_ROWSQ = 262144;
constexpr size_t WS_MODACC = 65536;
constexpr size_t WS_ROPE = 1 * MiB;
constexpr size_t WS_WIN = 2 * MiB;
constexpr size_t WS_WOUT = 66 * MiB;
constexpr size_t WS_HX = 82 * MiB;
constexpr size_t WS_U = 115 * MiB;
constexpr size_t WS_CAT = 247 * MiB;
constexpr size_t WS_X1 = 280 * MiB;
constexpr size_t WS_KV = 346 * MiB;
constexpr size_t WS_SP = 412 * MiB;
constexpr size_t WS_END = 445 * MiB;

struct Args { const float* in[15]; float* out; unsigned char* ws; };

#define LDS_WAIT() asm volatile("s_waitcnt lgkmcnt(0)" ::: "memory")
__device__ __forceinline__ unsigned cvt_pk(float lo, float hi) { unsigned r; asm volatile("v_cvt_pk_bf16_f32 %0, %1, %2" : "=v"(r) : "v"(lo), "v"(hi)); return r; }
__device__ __forceinline__ float bflo(unsigned u) { return __uint_as_float(u << 16); }
__device__ __forceinline__ float bfhi(unsigned u) { return __uint_as_float(u & 0xffff0000u); }
__device__ __forceinline__ float wave_sum(float v) {
#pragma unroll
    for (int o = 1; o < 64; o <<= 1) v += __shfl_xor(v, o);
    return v;
}
__device__ __forceinline__ float fexp2(float x) { return __builtin_amdgcn_exp2f(x); }
__device__ __forceinline__ float frsq(float x) { return __builtin_amdgcn_rsqf(x); }
__device__ __forceinline__ float silu_f(float z) { return z * __builtin_amdgcn_rcpf(1.f + __builtin_amdgcn_exp2f(-1.4426950408889634f * z)); }

__device__ __forceinline__ int conv_slot_of_col(int s) { const int Q = s >> 10, ch = s & 1023, pn = ch >> 6, r = ch & 63; return 256 * pn + 128 * (Q & 1) + 32 * (r >> 4) + 8 * ((r >> 2) & 3) + 4 * (Q >> 1) + (r & 3); }
__device__ __forceinline__ int qk_slot_of_dim(int d) { const int half = d >> 6, n = (d >> 5) & 1, f = d & 31; return 32 * (2 * half + (f >> 4)) + 8 * ((f >> 2) & 3) + 4 * n + (f & 3); }

__device__ __forceinline__ void transpose_item(const float* __restrict__ W, int K, int N, bf16_t* __restrict__ WT, LAS float* scr, int item, int lane, bool permqk) {
    const int nblk = N / 32, kb = item / nblk, nb = item % nblk, k0 = 64 * kb, n0 = 32 * nb;
#pragma unroll 8
    for (int i = 0; i < 32; ++i) { const int kk = 2 * i + (lane >> 5); scr[kk * 33 + (lane & 31)] = W[(size_t)(k0 + kk) * N + n0 + (lane & 31)]; }
    LDS_WAIT(); asm volatile("" ::: "memory");
    const int c = lane & 7;
#pragma unroll
    for (int j = 0; j < 4; ++j) { const int n = (lane >> 3) + 8 * j; const LAS float* s = scr + (8 * c) * 33 + n;
        u32x4 o; o.x = cvt_pk(s[0 * 33], s[1 * 33]); o.y = cvt_pk(s[2 * 33], s[3 * 33]); o.z = cvt_pk(s[4 * 33], s[5 * 33]); o.w = cvt_pk(s[6 * 33], s[7 * 33]);
        int dst = n0 + n;
        if (permqk && dst >= 4096 && dst < 6144) dst = (dst & ~127) + qk_slot_of_dim(dst & 127);
        *(u32x4*)(WT + (size_t)dst * K + k0 + 8 * c) = o; }
    LDS_WAIT(); asm volatile("" ::: "memory");
}

__device__ __forceinline__ void my_sincos(double a, double& s, double& c) {
    const double n = rint(a * 0.63661977236758134308);
    double r = fma(-n, 1.57079632679489655800, a); r = fma(-n, 6.12323399573676603587e-17, r);
    const double r2 = r * r;
    double ps = 1.0 / 6227020800.0; ps = ps * r2 - 1.0 / 39916800.0; ps = ps * r2 + 1.0 / 362880.0; ps = ps * r2 - 1.0 / 5040.0; ps = ps * r2 + 1.0 / 120.0; ps = ps * r2 - 1.0 / 6.0; ps = ps * r2 + 1.0; ps *= r;
    double pc = -1.0 / 87178291200.0; pc = pc * r2 + 1.0 / 479001600.0; pc = pc * r2 - 1.0 / 3628800.0; pc = pc * r2 + 1.0 / 40320.0; pc = pc * r2 - 1.0 / 720.0; pc = pc * r2 + 1.0 / 24.0; pc = pc * r2 - 0.5; pc = pc * r2 + 1.0;
    const int q = ((int)n) & 3;
    s = (q == 0) ? ps : (q == 1) ? pc : (q == 2) ? -ps : -pc;
    c = (q == 0) ? pc : (q == 1) ? -ps : (q == 2) ? -pc : ps;
}

__device__ __forceinline__ void mod_gemv(const Args& A, LAS unsigned char* lds, int layer, int vb_, int nvb_, int tid, int lane, int wave) {
    asm volatile("" : "+v"(tid)); lane = tid & 63;
    unsigned char* ws = A.ws; const int it0 = layer * 192;
    { const float* cvec = A.in[1]; const float* cctx = A.in[3]; const float* wmod = A.in[5]; const float* bmod = A.in[6];
      float* modacc = (float*)(ws + WS_MODACC);
      LAS float* red = (LAS float*)lds;
      for (int it = it0 + vb_; it < it0 + 192; it += nvb_) {
          const int l = it / 192, r = it % 192, strip = r / 16, kb = r % 16;
          const float* Wm = wmod + (size_t)l * 2048 * 6144 + strip * 512 + lane * 4;
          f32x4 a1[2], a2[2];
          a1[0] = a1[1] = a2[0] = a2[1] = (f32x4){0.f, 0.f, 0.f, 0.f};
#pragma unroll
          for (int rr = 0; rr < 16; ++rr) { const int k = kb * 128 + wave * 16 + rr;
              const float s1 = silu_f(cvec[k]), s2 = silu_f(cctx[k]);
#pragma unroll
              for (int p = 0; p < 2; ++p) { const f32x4 w = __builtin_nontemporal_load((const f32x4*)(Wm + (size_t)k * 6144 + p * 256)); a1[p] += w * s1; a2[p] += w * s2; } }
#pragma unroll
          for (int p = 0; p < 2; ++p) { *(LAS f32x4*)(red + (wave * 2 + 0) * 512 + p * 256 + lane * 4) = a1[p]; *(LAS f32x4*)(red + (wave * 2 + 1) * 512 + p * 256 + lane * 4) = a2[p]; }
          __syncthreads();
#pragma unroll
          for (int vec = 0; vec < 2; ++vec) { float s = 0.f;
#pragma unroll
              for (int w = 0; w < 8; ++w) s += red[(w * 2 + vec) * 512 + tid];
              if (kb == 0) s += bmod[l * 6144 + strip * 512 + tid];
              atomicAdd(modacc + (size_t)(l * 2 + vec) * 6144 + strip * 512 + tid, s); }
          __syncthreads();
      } }
}

__device__ __forceinline__ void convert_weights(const Args& A, LAS unsigned char* lds, int l, int it_begin, int it_end, int vw, int nvw, int lane, int wave) {
    asm volatile("" : "+v"(lane));
    unsigned char* ws = A.ws;
    LAS float* scr = (LAS float*)(lds + wave * 16384);
    constexpr int I_IN = (2048 / 64) * (8192 / 32), I_OUT = (2048 / 64) * (2048 / 32); const int NIT = it_end;
    const float* w_in = A.in[7] + (size_t)l * 2048 * 8192; const float* w_out = A.in[13] + (size_t)l * 2048 * 2048;
    bf16_t* WinT = (bf16_t*)(ws + WS_WIN) + (size_t)l * 8192 * 2048; bf16_t* WoT = (bf16_t*)(ws + WS_WOUT) + (size_t)l * 2048 * 2048;
#define T_DECODE(it, W, N, WT, perm, k0, n0) do { int r_ = (it); if (r_ < I_IN) { W = w_in; N = 8192; WT = WinT; perm = true; } else { r_ -= I_IN; W = w_out; N = 2048; WT = WoT; perm = false; } \
        const int nblk_ = N / 32; k0 = 64 * (r_ / nblk_); n0 = 32 * (r_ % nblk_); } while (0)
    for (int rep_t = 0; rep_t < REP_T; ++rep_t) {
    int it = it_begin + vw;
    float cur[32], nx1[32];
#define T_LOADS(dst, item) do { const int ic_ = (item) < NIT ? (item) : NIT - 1; const float* W_; int N_, k_, n_; bf16_t* WT_; bool p_; T_DECODE(ic_, W_, N_, WT_, p_, k_, n_); (void)WT_; (void)p_; \
        _Pragma("unroll") for (int i = 0; i < 32; ++i) dst[i] = __builtin_nontemporal_load(W_ + (size_t)(k_ + 2 * i + (lane >> 5)) * N_ + n_ + (lane & 31)); } while (0)
#define T_PROCESS(buf, item) do { const float* W; int N, k0, n0; bf16_t* WT; bool perm; T_DECODE(item, W, N, WT, perm, k0, n0); (void)W; \
        _Pragma("unroll") for (int i = 0; i < 32; ++i) scr[(2 * i + (lane >> 5)) * 33 + (lane & 31)] = buf[i]; \
        T_LOADS(buf, (item) + 2 * nvw); \
        __builtin_amdgcn_sched_barrier(0); \
        LDS_WAIT(); asm volatile("" ::: "memory"); \
        const int c = lane & 7; \
        _Pragma("unroll") for (int j = 0; j < 4; ++j) { const int n = (lane >> 3) + 8 * j; const LAS float* s = scr + (8 * c) * 33 + n; \
            u32x4 o; o.x = cvt_pk(s[0 * 33], s[1 * 33]); o.y = cvt_pk(s[2 * 33], s[3 * 33]); o.z = cvt_pk(s[4 * 33], s[5 * 33]); o.w = cvt_pk(s[6 * 33], s[7 * 33]); \
            int dst = n0 + n; \
            if (perm) { if (dst < 4096) dst = conv_slot_of_col(dst); else if (dst < 6144) dst = (dst & ~127) + qk_slot_of_dim(dst & 127); } \
            *(u32x4*)(WT + (size_t)dst * 2048 + k0 + 8 * c) = o; } \
        LDS_WAIT(); asm volatile("" ::: "memory"); } while (0)
    T_LOADS(cur, it); T_LOADS(nx1, it + nvw);
    while (it < NIT) {
        T_PROCESS(cur, it);
        it += nvw; if (it >= NIT) break;
        T_PROCESS(nx1, it);
        it += nvw;
    } }
#undef T_PROCESS
#undef T_LOADS
#undef T_DECODE
}

__device__ __forceinline__ void phase0(const Args& A, LAS unsigned char* lds, int tid, int lane, int wave) {
    unsigned char* ws = A.ws;
    const int G = gridDim.x, bx = blockIdx.x;
    { const int t = bx * NTHREADS + tid;
      if (t < 4096) { const int pos = t >> 5, fi = t & 31; double inv = 1.0; for (int i = 0; i < fi; ++i) inv *= 0.74989420933245582730;
          double s, c; my_sincos((double)pos * inv, s, c); float* rp = (float*)(ws + WS_ROPE); rp[t] = (float)c; rp[4096 + t] = (float)s; } }
    mod_gemv(A, lds, 0, bx, G, tid, lane, wave);
    convert_weights(A, lds, 0, 0, 10240, bx * NWAVES + wave, G * NWAVES, lane, wave);
}

__device__ __forceinline__ void norm_mod_rows(const float* __restrict__ src, int nrows, bf16_t* __restrict__ dst, const float* __restrict__ nw, const float* __restrict__ shift, const float* __restrict__ scale, int gw, int NGW, int lane) {
    if (gw >= nrows) return;
    asm volatile("" : "+v"(lane));
    f32x4 ca[8], cb[8];
#pragma unroll
    for (int j = 0; j < 8; ++j) { const int c = 4 * lane + 256 * j; const f32x4 w = *(const f32x4*)(nw + c), sc = *(const f32x4*)(scale + c); ca[j] = w * (sc + 1.f); cb[j] = *(const f32x4*)(shift + c); }
    f32x4 nx[8];
    { const f32x4* xr = (const f32x4*)(src + (size_t)gw * D) + lane;
#pragma unroll
      for (int j = 0; j < 8; ++j) nx[j] = __builtin_nontemporal_load(xr + 64 * j); }
    for (int m = gw; m < nrows; m += NGW) {
        f32x4 v[8]; float s = 0.f;
#pragma unroll
        for (int j = 0; j < 8; ++j) { v[j] = nx[j]; s += (v[j].x * v[j].x + v[j].y * v[j].y) + (v[j].z * v[j].z + v[j].w * v[j].w); }
        { const int m2 = (m + NGW < nrows) ? m + NGW : m; const f32x4* xr = (const f32x4*)(src + (size_t)m2 * D) + lane;
#pragma unroll
          for (int j = 0; j < 8; ++j) nx[j] = __builtin_nontemporal_load(xr + 64 * j); }
        __builtin_amdgcn_sched_barrier(0);
        const float rstd = frsq(wave_sum(s) * (1.f / D) + EPS);
        u32x2* o8 = (u32x2*)(dst + (size_t)m * D) + lane;
#pragma unroll
        for (int j = 0; j < 8; ++j) { const f32x4 y = v[j] * rstd * ca[j] + cb[j]; u32x2 w; w.x = cvt_pk(y.x, y.y); w.y = cvt_pk(y.z, y.w); o8[64 * j] = w; }
    }
}
__device__ __forceinline__ void final_norm_rows(const float* __restrict__ src, int nrows, float* __restrict__ dst, const float* __restrict__ nw, int gw, int NGW, int lane) {
    f32x4 ca[8];
#pragma unroll
    for (int j = 0; j < 8; ++j) ca[j] = *(const f32x4*)(nw + 4 * lane + 256 * j);
    if (gw >= nrows) return;
    f32x4 nx[8];
    { const f32x4* xr = (const f32x4*)(src + (size_t)gw * D) + lane;
#pragma unroll
      for (int j = 0; j < 8; ++j) nx[j] = __builtin_nontemporal_load(xr + 64 * j); }
    for (int m = gw; m < nrows; m += NGW) {
        f32x4 v[8]; float s = 0.f;
#pragma unroll
        for (int j = 0; j < 8; ++j) { v[j] = nx[j]; s += (v[j].x * v[j].x + v[j].y * v[j].y) + (v[j].z * v[j].z + v[j].w * v[j].w); }
        { const int m2 = (m + NGW < nrows) ? m + NGW : m; const f32x4* xr = (const f32x4*)(src + (size_t)m2 * D) + lane;
#pragma unroll
          for (int j = 0; j < 8; ++j) nx[j] = __builtin_nontemporal_load(xr + 64 * j); }
        __builtin_amdgcn_sched_barrier(0);
        const float rstd = frsq(wave_sum(s) * (1.f / D) + EPS);
        f32x4* o = (f32x4*)(dst + (size_t)m * D) + lane;
#pragma unroll
        for (int j = 0; j < 8; ++j) __builtin_nontemporal_store(v[j] * rstd * ca[j], o + 64 * j);
    }
}

__device__ __forceinline__ unsigned off_b(unsigned row, unsigned ch) { return 256u * row + 16u * (ch ^ (((row & 3) << 2) | ((row >> 2) & 3))); }
__device__ __forceinline__ unsigned rbase_of(int lane) { const unsigned li = lane & 15, g = lane >> 4; return 256u * li + 16u * (((li & 3) << 2) | (g ^ (li >> 2))); }
__device__ __forceinline__ unsigned tbase_of(int lane) { const unsigned g = lane >> 4, q = (lane & 15) >> 2, p = lane & 3; return 256u * (8 * g + q) + 16u * (((q << 2) | (2 * (g & 1))) ^ (p >> 1)) + 8u * (p & 1); }
__device__ __forceinline__ unsigned pbase_of(int lane) { const unsigned g = lane >> 4, q = (lane & 15) >> 2, p = lane & 3; return 256u * (4 * g + q) + 16u * (((q << 2) | g) ^ (p >> 1)) + 8u * (p & 1); }
__device__ __forceinline__ bf16x8 rowfrag(LAS const unsigned char* tile, unsigned rbase, int rb, int s) { return *(LAS const bf16x8*)(tile + (rbase ^ (unsigned)(s << 6)) + rb * 4096); }
__device__ __forceinline__ bf16x8 trfrag(LAS const unsigned char* tile, unsigned tbase, int c, int ks) {
    const s16x4 lo = __builtin_amdgcn_ds_read_tr16_b64_v4i16((LAS s16x4*)(tile + (tbase ^ (unsigned)(c * 32)) + ks * 8192));
    const s16x4 hi = __builtin_amdgcn_ds_read_tr16_b64_v4i16((LAS s16x4*)(tile + (tbase ^ (unsigned)(c * 32 + 16)) + ks * 8192 + 1024));
    return (bf16x8){lo[0], lo[1], lo[2], lo[3], hi[0], hi[1], hi[2], hi[3]};
}
__device__ __forceinline__ bf16x8 trfrag_p(LAS const unsigned char* tile, unsigned pbase, int c, int sp) {
    const s16x4 lo = __builtin_amdgcn_ds_read_tr16_b64_v4i16((LAS s16x4*)(tile + (pbase ^ (unsigned)(c * 32)) + sp * 8192));
    const s16x4 hi = __builtin_amdgcn_ds_read_tr16_b64_v4i16((LAS s16x4*)(tile + (pbase ^ (unsigned)(c * 32)) + sp * 8192 + 4096));
    return (bf16x8){lo[0], lo[1], lo[2], lo[3], hi[0], hi[1], hi[2], hi[3]};
}
__device__ __forceinline__ void load_tile(const bf16_t* __restrict__ src, size_t ld, LAS unsigned char* tile, int tid) {
#pragma unroll
    for (int i = 0; i < 4; ++i) { const int q = tid + 512 * i, row = q >> 4, ch = q & 15;
        const u32x4 v = *(const u32x4*)(src + (size_t)row * ld + ch * 8);
        *(LAS u32x4*)(tile + off_b(row, ch)) = v; }
}

__device__ __forceinline__ void kv_tiles_request(const bf16_t* __restrict__ U, int n, int h, int tid, u32x4 (&pre)[8]) {
    asm volatile("" : "+v"(tid));
    const bf16_t* ub = U + (size_t)n * 128 * DIN + h * 128 + 5120;
    const unsigned row0 = tid >> 4, ch8 = (tid & 15) * 8;
#pragma unroll
    for (int i = 0; i < 4; ++i) { const unsigned uo = (row0 + 32 * i) * DIN + ch8; pre[i] = *(const u32x4*)(ub + uo); pre[4 + i] = *(const u32x4*)(ub + uo + 1024); }
}
__device__ __forceinline__ void kv_unit(const bf16_t* __restrict__ U, bf16_t* __restrict__ KV, int n, int h, float l2f, float l2b, LAS unsigned char* lds, int tid, int lane, int wave,
                                        u32x4 (&pre)[8], bool has_next, int n2, int h2) {
    asm volatile("" : "+v"(tid)); lane = tid & 63;
    LAS unsigned char* Kf = lds, *Kb = lds + 32768, *Vt = lds + 65536;
#pragma unroll
    for (int i = 0; i < 4; ++i) { const int q = tid + 512 * i, row = q >> 4, ch = q & 15;
        const u32x4 kv = pre[i];
        const u32x4 vv = pre[4 + i];
        const float wf = fexp2(l2f * (float)(127 - row)), wb = fexp2(l2b * (float)row);
        u32x4 a, b;
        a.x = cvt_pk(bflo(kv.x) * wf, bfhi(kv.x) * wf); a.y = cvt_pk(bflo(kv.y) * wf, bfhi(kv.y) * wf); a.z = cvt_pk(bflo(kv.z) * wf, bfhi(kv.z) * wf); a.w = cvt_pk(bflo(kv.w) * wf, bfhi(kv.w) * wf);
        b.x = cvt_pk(bflo(kv.x) * wb, bfhi(kv.x) * wb); b.y = cvt_pk(bflo(kv.y) * wb, bfhi(kv.y) * wb); b.z = cvt_pk(bflo(kv.z) * wb, bfhi(kv.z) * wb); b.w = cvt_pk(bflo(kv.w) * wb, bfhi(kv.w) * wb);
        const unsigned o = off_b(row, ch);
        *(LAS u32x4*)(Kf + o) = a; *(LAS u32x4*)(Kb + o) = b; *(LAS u32x4*)(Vt + o) = vv; }
    __builtin_amdgcn_sched_barrier(0);
    if (has_next) kv_tiles_request(U, n2, h2, tid, pre);
    __builtin_amdgcn_sched_barrier(0);
    __syncthreads();
    f32x4 accf[8], accb[8];
#pragma unroll
    for (int c = 0; c < 8; ++c) { accf[c] = (f32x4){0.f, 0.f, 0.f, 0.f}; accb[c] = (f32x4){0.f, 0.f, 0.f, 0.f}; }
    const int g = lane >> 4; const unsigned tb = tbase_of(lane);
#pragma unroll
    for (int ks = 0; ks < 4; ++ks) {
        const bf16x8 af = trfrag(Kf, tb, wave, ks), ab = trfrag(Kb, tb, wave, ks);
#pragma unroll
        for (int c = 0; c < 8; ++c) { const bf16x8 bv = trfrag(Vt, tb, c, ks);
            accf[c] = __builtin_amdgcn_mfma_f32_16x16x32_bf16(bv, af, accf[c], 0, 0, 0);
            accb[c] = __builtin_amdgcn_mfma_f32_16x16x32_bf16(bv, ab, accb[c], 0, 0, 0); }
    }
    bf16_t* of = KV + (size_t)((n * NH + h) * 2 + 0) * 16384 + (16 * wave + (lane & 15)) * 128 + 4 * g;
    bf16_t* ob = of + 16384;
#pragma unroll
#define KV_PK(lo, hi) ((((__float_as_uint(lo) + 0x7fffu + ((__float_as_uint(lo) >> 16) & 1u)) >> 16)) | (((__float_as_uint(hi) + 0x7fffu + ((__float_as_uint(hi) >> 16) & 1u)) >> 16) << 16))
    for (int c = 0; c < 8; ++c) { u32x2 wf_, wb_; wf_.x = KV_PK(accf[c][0], accf[c][1]); wf_.y = KV_PK(accf[c][2], accf[c][3]); wb_.x = KV_PK(accb[c][0], accb[c][1]); wb_.y = KV_PK(accb[c][2], accb[c][3]);
        *(u32x2*)(of + 16 * c) = wf_; *(u32x2*)(ob + 16 * c) = wb_; }
    __syncthreads();
}

__device__ __forceinline__ void load8(const bf16_t* p, float (&d)[8]) { const u32x4 v = *(const u32x4*)p; d[0] = bflo(v.x); d[1] = bfhi(v.x); d[2] = bflo(v.y); d[3] = bfhi(v.y); d[4] = bflo(v.z); d[5] = bfhi(v.z); d[6] = bflo(v.w); d[7] = bfhi(v.w); }
__device__ __forceinline__ void conv_run(const bf16_t* __restrict__ U, bf16_t* __restrict__ CAT, LAS const float* wt  , int t0, int s0, int s1, int lane) {
    asm volatile("" : "+v"(lane));
    const bf16_t* ub = U + 8 * lane;
    const u32x4 zero4 = (u32x4){0u, 0u, 0u, 0u};
#define RAW_LOAD(dst, t) do { const bool in_ = ((t) + 1 >= s0 && (t) + 1 < s1); const size_t rg_ = (size_t)(in_ ? (t) + 1 : (t)) * DIN; const size_t rt_ = (size_t)(t) * DIN; \
        dst[0] = *(const u32x4*)(ub + rg_); dst[1] = *(const u32x4*)(ub + rg_ + 512); dst[2] = *(const u32x4*)(ub + rg_ + 2048); dst[3] = *(const u32x4*)(ub + rg_ + 2048 + 512); \
        dst[4] = *(const u32x4*)(ub + rt_ + 1024); dst[5] = *(const u32x4*)(ub + rt_ + 1024 + 512); dst[6] = *(const u32x4*)(ub + rt_ + 3072); dst[7] = *(const u32x4*)(ub + rt_ + 3072 + 512); \
        if (!in_) { dst[0] = zero4; dst[1] = zero4; dst[2] = zero4; dst[3] = zero4; } } while (0)
#define UNPK(v, d) do { d[0] = bflo(v.x); d[1] = bfhi(v.x); d[2] = bflo(v.y); d[3] = bfhi(v.y); d[4] = bflo(v.z); d[5] = bfhi(v.z); d[6] = bflo(v.w); d[7] = bfhi(v.w); } while (0)
    u32x4 pre[4], cur[8];
    { const bool in_ = (t0 - 1 >= s0); const size_t r_ = (size_t)(in_ ? t0 - 1 : t0) * DIN;
      pre[0] = *(const u32x4*)(ub + r_); pre[1] = *(const u32x4*)(ub + r_ + 512); pre[2] = *(const u32x4*)(ub + r_ + 2048); pre[3] = *(const u32x4*)(ub + r_ + 2048 + 512);
      if (!in_) { pre[0] = zero4; pre[1] = zero4; pre[2] = zero4; pre[3] = zero4; } }
    u32x4 g0[4];
    { const size_t r_ = (size_t)t0 * DIN; g0[0] = *(const u32x4*)(ub + r_); g0[1] = *(const u32x4*)(ub + r_ + 512); g0[2] = *(const u32x4*)(ub + r_ + 2048); g0[3] = *(const u32x4*)(ub + r_ + 2048 + 512); }
    RAW_LOAD(cur, t0);
    __builtin_amdgcn_sched_barrier(0);
    float gp[16], gc[16], gn[16];
#define LDW(d, off) do { const f32x4 a_ = *(LAS const f32x4*)(wt + (off)), b_ = *(LAS const f32x4*)(wt + (off) + 4); d[0] = a_[0]; d[1] = a_[1]; d[2] = a_[2]; d[3] = a_[3]; d[4] = b_[0]; d[5] = b_[1]; d[6] = b_[2]; d[7] = b_[3]; } while (0)
#pragma unroll
    for (int jj = 0; jj < 2; ++jj) { float hh[8], cc[8]; UNPK(pre[jj], hh); UNPK(pre[2 + jj], cc);
#pragma unroll
        for (int e = 0; e < 8; ++e) gp[jj * 8 + e] = hh[e] * cc[e];
        UNPK(g0[jj], hh); UNPK(g0[2 + jj], cc);
#pragma unroll
        for (int e = 0; e < 8; ++e) gc[jj * 8 + e] = hh[e] * cc[e]; }
#pragma unroll
    for (int tt = 0; tt < 4; ++tt) {
        const int t = t0 + tt;
        float y[16]; float ss = 0.f;
#pragma unroll
        for (int jj = 0; jj < 2; ++jj) { float hh[8], cc[8], bb[8], a0[8], a1[8], a2[8]; UNPK(cur[jj], hh); UNPK(cur[2 + jj], cc); UNPK(cur[4 + jj], bb);
            const int cb = 8 * lane + 512 * jj; LDW(a0, cb); LDW(a1, 1024 + cb); LDW(a2, 2048 + cb);
#pragma unroll
            for (int e = 0; e < 8; ++e) { const int i = jj * 8 + e; gn[i] = hh[e] * cc[e]; y[i] = bb[e] * (a0[e] * gp[i] + a1[e] * gc[i] + a2[e] * gn[i]); ss += y[i] * y[i]; } }
        const u32x4 z0 = cur[6], z1 = cur[7];
        __builtin_amdgcn_sched_barrier(0);
        if (tt < 3) RAW_LOAD(cur, t + 1);
        __builtin_amdgcn_sched_barrier(0);
        const float rstd = frsq(wave_sum(ss) * (1.f / DCONV) + EPS);
#pragma unroll
        for (int jj = 0; jj < 2; ++jj) { float zz[8], an[8]; if (jj == 0) UNPK(z0, zz); else UNPK(z1, zz); LDW(an, 3072 + 8 * lane + 512 * jj); float o[8];
#pragma unroll
            for (int e = 0; e < 8; ++e) { const int i = jj * 8 + e; o[e] = silu_f(zz[e]) * (y[i] * rstd * an[e]); }
            u32x4 w; w.x = cvt_pk(o[0], o[1]); w.y = cvt_pk(o[2], o[3]); w.z = cvt_pk(o[4], o[5]); w.w = cvt_pk(o[6], o[7]);
            *(u32x4*)(CAT + (size_t)t * D + 8 * lane + 512 * jj) = w; }
#pragma unroll
        for (int e = 0; e < 16; ++e) { gp[e] = gc[e]; gc[e] = gn[e]; }
        __builtin_amdgcn_sched_barrier(0);
    }
#undef RAW_LOAD
#undef UNPK
#undef LDW
}

__device__ __forceinline__ void conv_fix_row(const bf16_t* __restrict__ U, bf16_t* __restrict__ CAT, const float* __restrict__ cw, const float* __restrict__ cnw, int t, int s0, int s1, int lane) {
    asm volatile("" : "+v"(lane));
    const int cb = 64 * (lane >> 2) + 16 * (lane & 3), ub = 256 * (lane >> 2) + 32 * (lane & 3);
    const u32x4 z4 = (u32x4){0u, 0u, 0u, 0u};
    u32x4 rp[4], rc[4], rn[4], rb[4];
    const bool hp = (t - 1 >= s0), hn = (t + 1 < s1);
#pragma unroll
    for (int fq = 0; fq < 4; ++fq) {
        rp[fq] = *(const u32x4*)(U + (size_t)(hp ? t - 1 : t) * DIN + ub + 8 * fq);
        rc[fq] = *(const u32x4*)(U + (size_t)t * DIN + ub + 8 * fq);
        rn[fq] = *(const u32x4*)(U + (size_t)(hn ? t + 1 : t) * DIN + ub + 8 * fq);
        rb[fq] = *(const u32x4*)(U + (size_t)t * DIN + ub + 128 + 8 * fq);
        if (!hp) rp[fq] = z4; if (!hn) rn[fq] = z4; }
    float y[16], zz[16]; float ss = 0.f;
#pragma unroll
    for (int fq = 0; fq < 4; ++fq) {
        const f32x4 w0 = *(const f32x4*)(cw + cb + 4 * fq), w1 = *(const f32x4*)(cw + 1024 + cb + 4 * fq), w2 = *(const f32x4*)(cw + 2048 + cb + 4 * fq);
#define GV(v, j) ((j) == 0 ? bflo(v.x) * bflo(v.z) : (j) == 1 ? bfhi(v.x) * bfhi(v.z) : (j) == 2 ? bflo(v.y) * bflo(v.w) : bfhi(v.y) * bfhi(v.w))
#pragma unroll
        for (int j = 0; j < 4; ++j) { const float gp = GV(rp[fq], j), gc = GV(rc[fq], j), gn = GV(rn[fq], j);
            const float b = (j == 0) ? bflo(rb[fq].x) : (j == 1) ? bfhi(rb[fq].x) : (j == 2) ? bflo(rb[fq].y) : bfhi(rb[fq].y);
            zz[4 * fq + j] = (j == 0) ? bflo(rb[fq].z) : (j == 1) ? bfhi(rb[fq].z) : (j == 2) ? bflo(rb[fq].w) : bfhi(rb[fq].w);
            const float yy = b * (w0[j] * gp + w1[j] * gc + w2[j] * gn); y[4 * fq + j] = yy; ss += yy * yy; }
#undef GV
    }
    const float rstd = frsq(wave_sum(ss) * (1.f / DCONV) + EPS);
#pragma unroll
    for (int hh = 0; hh < 2; ++hh) { float o[8];
#pragma unroll
        for (int e = 0; e < 8; ++e) { const int i = 8 * hh + e; o[e] = silu_f(zz[i]) * (y[i] * rstd * cnw[cb + i]); }
        u32x4 w; w.x = cvt_pk(o[0], o[1]); w.y = cvt_pk(o[2], o[3]); w.z = cvt_pk(o[4], o[5]); w.w = cvt_pk(o[6], o[7]);
        *(u32x4*)(CAT + (size_t)t * D + cb + 8 * hh) = w; }
}
__device__ __forceinline__ void conv_finish_rows(const bf16_t* __restrict__ U, bf16_t* __restrict__ CAT, const float* __restrict__ rowsq, const float* __restrict__ cw, const float* __restrict__ cnw, int t0, int lane) {
    asm volatile("" : "+v"(lane));
    u32x4 v[4][2]; float rs[4];
#pragma unroll
    for (int k = 0; k < 4; ++k) { const int t = t0 + k; v[k][0] = __builtin_nontemporal_load((const u32x4*)(CAT + (size_t)t * D + 16 * lane)); v[k][1] = __builtin_nontemporal_load((const u32x4*)(CAT + (size_t)t * D + 16 * lane + 8)); rs[k] = rowsq[t]; }
    __builtin_amdgcn_sched_barrier(0);
#pragma unroll
    for (int k = 0; k < 4; ++k) { const int t = t0 + k; const int r63 = t & 63;
        if (r63 == 0 || r63 == 63) continue;
        const float rstd = frsq(rs[k] * (1.f / DCONV) + EPS);
#pragma unroll
        for (int hh = 0; hh < 2; ++hh) { const u32x4 a = v[k][hh]; u32x4 w;
            w.x = cvt_pk(bflo(a.x) * rstd, bfhi(a.x) * rstd); w.y = cvt_pk(bflo(a.y) * rstd, bfhi(a.y) * rstd); w.z = cvt_pk(bflo(a.z) * rstd, bfhi(a.z) * rstd); w.w = cvt_pk(bflo(a.w) * rstd, bfhi(a.w) * rstd);
            *(u32x4*)(CAT + (size_t)t * D + 16 * lane + 8 * hh) = w; } }
#pragma unroll
    for (int k = 0; k < 4; ++k) { const int t = t0 + k; const int r63 = t & 63;
        if (r63 == 0 || r63 == 63) conv_fix_row(U, CAT, cw, cnw, t, 0, SEQ, lane); }
}

__device__ __forceinline__ void scan_phase(const bf16_t* __restrict__ KV, bf16_t* __restrict__ SP, const float* __restrict__ dec_f, const float* __restrict__ dec_b, int tid) {
    asm volatile("" : "+v"(tid));
    const int G = gridDim.x;
    for (int T = blockIdx.x * NTHREADS + tid; T < 16 * 8192; T += G * NTHREADS) {
        const int hd = T >> 13, e2 = T & 8191, h = hd >> 1, dir = hd & 1;
        const float lg = -expf(dir ? dec_b[h] : dec_f[h]);
        const float cd = fexp2(lg * LOG2E * 128.f);
        const size_t base = (size_t)(h * 2 + dir) * 16384 + 2 * e2;
        float s0 = 0.f, s1 = 0.f;
        const long cstride = (long)NH * 2 * 16384;
        const int c0 = dir ? 65 : 64, c1 = dir ? 64 : 65;
        const unsigned a0 = __builtin_nontemporal_load((const unsigned*)(KV + (size_t)c0 * cstride + base)), a1 = __builtin_nontemporal_load((const unsigned*)(KV + (size_t)c1 * cstride + base));
        const long step = dir ? -cstride : cstride;
        const bf16_t* kp = KV + (size_t)(dir ? 63 : 0) * cstride + base;
        bf16_t* sp = SP + (size_t)(dir ? 63 : 0) * cstride + base;
        unsigned cur[16], nxt[16];
#pragma unroll
        for (int j = 0; j < 16; ++j) cur[j] = __builtin_nontemporal_load((const unsigned*)(kp + j * step));
        *(unsigned*)(SP + (size_t)c0 * cstride + base) = 0u;
        s0 = bflo(a0); s1 = bfhi(a0);
        *(unsigned*)(SP + (size_t)c1 * cstride + base) = cvt_pk(s0, s1);
        s0 = cd * s0 + bflo(a1); s1 = cd * s1 + bfhi(a1);
#pragma unroll 1
        for (int b = 0; b < 4; ++b) {
            const long nb = (b < 3) ? 16 * step : 0;
#pragma unroll
            for (int j = 0; j < 16; ++j) nxt[j] = __builtin_nontemporal_load((const unsigned*)(kp + nb + j * step));
            __builtin_amdgcn_sched_barrier(0);
#pragma unroll
            for (int j = 0; j < 16; ++j) { *(unsigned*)(sp + j * step) = cvt_pk(s0, s1); s0 = cd * s0 + bflo(cur[j]); s1 = cd * s1 + bfhi(cur[j]); }
            __builtin_amdgcn_sched_barrier(0);
            kp += 16 * step; sp += 16 * step;
#pragma unroll
            for (int j = 0; j < 16; ++j) cur[j] = nxt[j];
        }
    }
}

__device__ __forceinline__ void ret_tiles_request(const bf16_t* __restrict__ U, int n, int h, int tid, u32x4 (&pre)[12]) {
    asm volatile("" : "+v"(tid));
    const bf16_t* ub = U + (size_t)n * 128 * DIN + h * 128 + 4096;
    const unsigned row0 = tid >> 4, ch8 = (tid & 15) * 8;
#pragma unroll
    for (int i = 0; i < 4; ++i) { const unsigned uo = (row0 + 32 * i) * DIN + ch8; pre[i] = __builtin_nontemporal_load((const u32x4*)(ub + uo)); pre[4 + i] = __builtin_nontemporal_load((const u32x4*)(ub + uo + 1024)); pre[8 + i] = __builtin_nontemporal_load((const u32x4*)(ub + uo + 2048)); }
}
template <int VAR>
__device__ __forceinline__ void ret_unit(const bf16_t* __restrict__ U, const bf16_t* __restrict__ SP, bf16_t* __restrict__ CAT, const float* __restrict__ gnw, int n, int h, float l2f, float l2b,
                                         LAS unsigned char* lds, int tid, int lane, int wave, u32x4 (&pre)[12], bool has_next, int n2, int h2) {
    asm volatile("" : "+v"(tid));
    LAS unsigned char* Qt = lds, *Kt = lds + 32768, *Vt = lds + 65536, *St = lds + 98304;
    const size_t r0 = (size_t)n * 128;
    const bf16_t* spf = SP + (size_t)((n * NH + h) * 2) * 16384;
#pragma unroll
    for (int i = 0; i < 4; ++i) { const int q = tid + 512 * i; const unsigned o = off_b(q >> 4, q & 15); *(LAS u32x4*)(Qt + o) = pre[i]; *(LAS u32x4*)(Kt + o) = pre[4 + i]; *(LAS u32x4*)(Vt + o) = pre[8 + i]; }
    asm volatile("" : "+v"(lane));
    u32x4 sfr[4], sbr[4]; unsigned zr[16];
#pragma unroll
    for (int i = 0; i < 4; ++i) { const int q = tid + 512 * i, row = q >> 4, ch = q & 15;
        sfr[i] = __builtin_nontemporal_load((const u32x4*)(spf + (size_t)row * 128 + ch * 8));
        sbr[i] = __builtin_nontemporal_load((const u32x4*)(spf + 16384 + (size_t)row * 128 + ch * 8)); }
    __builtin_amdgcn_sched_barrier(0);
    __syncthreads();
    const int g = lane >> 4, li = lane & 15; const unsigned rb_ = rbase_of(lane), tb = tbase_of(lane), pb = pbase_of(lane);
    bf16x8 qf[4];
#pragma unroll
    for (int s = 0; s < 4; ++s) qf[s] = rowfrag(Qt, rb_, wave, s);
    bf16x8 pf[4];
#pragma unroll
    for (int sp = 0; sp < 4; ++sp) {
        f32x4 sa = (f32x4){0.f, 0.f, 0.f, 0.f}, sb = (f32x4){0.f, 0.f, 0.f, 0.f};
#pragma unroll
        for (int s = 0; s < 4; ++s) { sa = __builtin_amdgcn_mfma_f32_16x16x32_bf16(rowfrag(Kt, rb_, 2 * sp, s), qf[s], sa, 0, 0, 0);
                                      sb = __builtin_amdgcn_mfma_f32_16x16x32_bf16(rowfrag(Kt, rb_, 2 * sp + 1, s), qf[s], sb, 0, 0, 0); }
        const int i = 16 * wave + li;
        float pa[4], pb2[4];
#pragma unroll
        for (int r = 0; r < 4; ++r) {
            const int ja = 32 * sp + 4 * g + r, jb = ja + 16;
            const int da = i - ja, db = i - jb;
            const float ea = fexp2((da > 0 ? l2f : l2b) * (float)(da < 0 ? -da : da)), eb = fexp2((db > 0 ? l2f : l2b) * (float)(db < 0 ? -db : db));
            const float ma = (da == 0) ? 2.f : ea, mb = (db == 0) ? 2.f : eb;
            pa[r] = sa[r] * ma; pb2[r] = sb[r] * mb; }
        const unsigned w0 = cvt_pk(pa[0], pa[1]), w1 = cvt_pk(pa[2], pa[3]), w2 = cvt_pk(pb2[0], pb2[1]), w3 = cvt_pk(pb2[2], pb2[3]);
        const u32x4 w = (u32x4){w0, w1, w2, w3};
        pf[sp] = __builtin_bit_cast(bf16x8, w);
        __builtin_amdgcn_sched_barrier(0);
    }
    f32x4 accO[8], accF[8];
#pragma unroll
    for (int c = 0; c < 8; ++c) { accO[c] = (f32x4){0.f, 0.f, 0.f, 0.f}; accF[c] = (f32x4){0.f, 0.f, 0.f, 0.f}; }
#pragma unroll
    for (int sp = 0; sp < 4; ++sp) {
#pragma unroll
        for (int c = 0; c < 8; ++c) accO[c] = __builtin_amdgcn_mfma_f32_16x16x32_bf16(pf[sp], trfrag_p(Vt, pb, c, sp), accO[c], 0, 0, 0);
        __builtin_amdgcn_sched_barrier(0); }
    { const bf16_t* zp = U + (r0 + 16 * wave) * DIN + 7168 + h * 128 + 2 * lane;
#pragma unroll
      for (int rr = 0; rr < 16; ++rr) zr[rr] = __builtin_nontemporal_load((const unsigned*)(zp + (size_t)rr * DIN)); }
    __builtin_amdgcn_sched_barrier(0);
    __syncthreads();
#pragma unroll
    for (int i = 0; i < 4; ++i) { const int q = tid + 512 * i; const unsigned o = off_b(q >> 4, q & 15); *(LAS u32x4*)(St + o) = sfr[i]; *(LAS u32x4*)(Qt + o) = sbr[i]; }
    __syncthreads();
    float qdf[4], qdb[4];
#pragma unroll
    for (int r = 0; r < 4; ++r) { const int i = 16 * wave + 4 * g + r; qdf[r] = fexp2(l2f * (float)(i + 1)); qdb[r] = fexp2(l2b * (float)(128 - i)); }
#pragma unroll
    for (int s = 0; s < 4; ++s) {
#pragma unroll
        for (int c = 0; c < 8; ++c) accF[c] = __builtin_amdgcn_mfma_f32_16x16x32_bf16(qf[s], trfrag(St, tb, c, s), accF[c], 0, 0, 0);
        __builtin_amdgcn_sched_barrier(0); }
#pragma unroll
    for (int c = 0; c < 8; ++c)
#pragma unroll
        for (int r = 0; r < 4; ++r) accO[c][r] += qdf[r] * accF[c][r];
#pragma unroll
    for (int c = 0; c < 8; ++c) accF[c] = (f32x4){0.f, 0.f, 0.f, 0.f};
#pragma unroll
    for (int s = 0; s < 4; ++s) {
#pragma unroll
        for (int c = 0; c < 8; ++c) accF[c] = __builtin_amdgcn_mfma_f32_16x16x32_bf16(qf[s], trfrag(Qt, tb, c, s), accF[c], 0, 0, 0);
        __builtin_amdgcn_sched_barrier(0); }
#pragma unroll
    for (int c = 0; c < 8; ++c)
#pragma unroll
        for (int r = 0; r < 4; ++r) accO[c][r] += qdb[r] * accF[c][r];
    LAS float* stg = (LAS float*)(lds + 32768 + wave * 8192);
#pragma unroll
    for (int r = 0; r < 4; ++r) {
        float s = 0.f;
#pragma unroll
        for (int c = 0; c < 8; ++c) s += accO[c][r];
#pragma unroll
        for (int o = 1; o < 16; o <<= 1) s += __shfl_xor(s, o);
        const float mu = s * (1.f / 128.f);
        float v = 0.f;
#pragma unroll
        for (int c = 0; c < 8; ++c) { const float d = accO[c][r] - mu; v += d * d; }
#pragma unroll
        for (int o = 1; o < 16; o <<= 1) v += __shfl_xor(v, o);
        const float rstd = frsq(v * (1.f / 128.f) + EPS);
#pragma unroll
        for (int c = 0; c < 8; ++c) stg[(4 * g + r) * 128 + 16 * c + li] = (accO[c][r] - mu) * rstd;
    }
    LDS_WAIT();
    __builtin_amdgcn_sched_barrier(0);
    if (has_next) ret_tiles_request(U, n2, h2, tid, pre);
    __builtin_amdgcn_sched_barrier(0);
    { const float gn0 = gnw[h * 128 + 2 * lane], gn1 = gnw[h * 128 + 2 * lane + 1];
      bf16_t* op = CAT + (r0 + 16 * wave) * D + 1024 + h * 128 + 2 * lane;
#pragma unroll
      for (int rr = 0; rr < 16; ++rr) {
          const float v0 = stg[rr * 128 + 2 * lane], v1 = stg[rr * 128 + 2 * lane + 1];
          const unsigned z = zr[rr];
          *(unsigned*)(op + (size_t)rr * D) = cvt_pk(silu_f(bflo(z)) * v0 * gn0, silu_f(bfhi(z)) * v1 * gn1); } }
    __syncthreads();
}

template <int MI, int NI, int MODE>
__device__ __forceinline__ void small_gemm(const bf16_t* __restrict__ A, const bf16_t* __restrict__ WT, int m0, int n0, int lane,
                                           bf16_t* __restrict__ Uc, const float* __restrict__ resid, const float* __restrict__ gate, float* __restrict__ Xc) {
    asm volatile("" : "+v"(lane));
    const int li = lane & 15, g = lane >> 4;
    const bf16_t* ap = A + (size_t)(m0 + li) * 2048 + 8 * g;
    const bf16_t* bp = WT + (size_t)(n0 + li) * 2048 + 8 * g;
    f32x4 acc[MI][NI];
#pragma unroll
    for (int mi = 0; mi < MI; ++mi)
#pragma unroll
        for (int ni = 0; ni < NI; ++ni) acc[mi][ni] = (f32x4){0.f, 0.f, 0.f, 0.f};
    bf16x8 fa[2][8][MI], fb[2][8][NI];
#define SG_LOAD(buf, kb) do { _Pragma("unroll") for (int j = 0; j < 8; ++j) { _Pragma("unroll") for (int mi = 0; mi < MI; ++mi) fa[buf][j][mi] = *(const bf16x8*)(ap + (size_t)mi * 16 * 2048 + ((kb) * 8 + j) * 32); \
        _Pragma("unroll") for (int ni = 0; ni < NI; ++ni) fb[buf][j][ni] = *(const bf16x8*)(bp + (size_t)ni * 16 * 2048 + ((kb) * 8 + j) * 32); } } while (0)
    SG_LOAD(0, 0);
#pragma unroll
    for (int kb = 0; kb < 8; ++kb) {
        if (kb + 1 < 8) { if (kb & 1) SG_LOAD(0, kb + 1); else SG_LOAD(1, kb + 1); }
        __builtin_amdgcn_sched_barrier(0);
#pragma unroll
        for (int j = 0; j < 8; ++j)
#pragma unroll
            for (int mi = 0; mi < MI; ++mi)
#pragma unroll
                for (int ni = 0; ni < NI; ++ni) acc[mi][ni] = __builtin_amdgcn_mfma_f32_16x16x32_bf16(fb[kb & 1][j][ni], fa[kb & 1][j][mi], acc[mi][ni], 0, 0, 0);
        __builtin_amdgcn_sched_barrier(0);
    }
#undef SG_LOAD
    int gq = g; asm volatile("" : "+v"(gq));
#pragma unroll
    for (int mi = 0; mi < MI; ++mi)
#pragma unroll
        for (int ni = 0; ni < NI; ++ni) {
            const int row = m0 + 16 * mi + li, col = n0 + 16 * ni + 4 * gq;
            if (MODE == 0) { const float sc = (col >= 5120 && col < 6144) ? 0.08838834764831845f : 1.f; const f32x4 v = acc[mi][ni] * sc;
                u32x2 w; w.x = cvt_pk(v[0], v[1]); w.y = cvt_pk(v[2], v[3]); *(u32x2*)(Uc + (size_t)row * DIN + col) = w; }
            else { const f32x4 r = *(const f32x4*)(resid + (size_t)row * D + col), gt = *(const f32x4*)(gate + col); *(f32x4*)(Xc + (size_t)row * D + col) = r + gt * acc[mi][ni]; }
        }
}

constexpr int SLAB_PITCH = 4112;
template <int NI, int MODE>
__device__ __forceinline__ void ctx_gemm_slab(const bf16_t* __restrict__ A, const bf16_t* __restrict__ WT, int m0, int n0, int tid, int wave, LAS unsigned char* lds,
                                              bf16_t* __restrict__ Uc, const float* __restrict__ resid, const float* __restrict__ gate, float* __restrict__ Xc) {
    asm volatile("" : "+v"(tid));
    const int lane = tid & 63, li = lane & 15, g = lane >> 4;
    { u32x4 t[16];
#pragma unroll
      for (int i = 0; i < 16; ++i) { const int q = tid + 512 * i; t[i] = *(const u32x4*)(A + (size_t)(m0 + (q >> 8)) * 2048 + (q & 255) * 8); }
#pragma unroll
      for (int i = 0; i < 16; ++i) { const int q = tid + 512 * i; *(LAS u32x4*)(lds + (q >> 8) * SLAB_PITCH + (q & 255) * 16) = t[i]; } }
    __syncthreads();
    const int nw0 = n0 + 16 * NI * wave;
    const bf16_t* bp = WT + (size_t)(nw0 + li) * 2048 + 8 * g;
    LAS const unsigned char* ap = lds + li * SLAB_PITCH + 16 * g;
    f32x4 acc[2][NI];
#pragma unroll
    for (int mi = 0; mi < 2; ++mi)
#pragma unroll
        for (int ni = 0; ni < NI; ++ni) acc[mi][ni] = (f32x4){0.f, 0.f, 0.f, 0.f};
    constexpr int KB = (NI == 1) ? 16 : 8, NB = 64 / KB;
    bf16x8 fb[2][KB][NI];
#define SL_LOAD(buf, kb) do { _Pragma("unroll") for (int j = 0; j < KB; ++j) { _Pragma("unroll") for (int ni = 0; ni < NI; ++ni) fb[buf][j][ni] = *(const bf16x8*)(bp + (size_t)ni * 16 * 2048 + ((kb) * KB + j) * 32); } } while (0)
    SL_LOAD(0, 0);
#pragma unroll
    for (int kb = 0; kb < NB; ++kb) {
        if (kb + 1 < NB) { if (kb & 1) SL_LOAD(0, kb + 1); else SL_LOAD(1, kb + 1); }
        __builtin_amdgcn_sched_barrier(0);
#pragma unroll
        for (int j = 0; j < KB; ++j) {
            bf16x8 a[2];
#pragma unroll
            for (int mi = 0; mi < 2; ++mi) a[mi] = *(LAS const bf16x8*)(ap + mi * 16 * SLAB_PITCH + (kb * KB + j) * 64);
#pragma unroll
            for (int mi = 0; mi < 2; ++mi)
#pragma unroll
                for (int ni = 0; ni < NI; ++ni) acc[mi][ni] = __builtin_amdgcn_mfma_f32_16x16x32_bf16(fb[kb & 1][j][ni], a[mi], acc[mi][ni], 0, 0, 0);
        }
        __builtin_amdgcn_sched_barrier(0);
    }
#undef SL_LOAD
    int gq = g; asm volatile("" : "+v"(gq));
#pragma unroll
    for (int mi = 0; mi < 2; ++mi)
#pragma unroll
        for (int ni = 0; ni < NI; ++ni) {
            const int row = m0 + 16 * mi + li, col = nw0 + 16 * ni + 4 * gq;
            if (MODE == 0) { const float sc = (col >= 5120 && col < 6144) ? 0.08838834764831845f : 1.f; const f32x4 v = acc[mi][ni] * sc;
                u32x2 w; w.x = cvt_pk(v[0], v[1]); w.y = cvt_pk(v[2], v[3]); *(u32x2*)(Uc + (size_t)row * DIN + col) = w; }
            else { const f32x4 r = *(const f32x4*)(resid + (size_t)row * D + col), gt = *(const f32x4*)(gate + col); *(f32x4*)(Xc + (size_t)row * D + col) = r + gt * acc[mi][ni]; }
        }
    __syncthreads();
}

#define XB_TMO      128
#define XB_XCNT(j)  (256  + 64 * (j))
#define XB_XSUB(j)  (1280 + 64 * (j))
#define XB_XGEN(j)  (2304 + 64 * (j))
#define XB_TOP      3328
#define XB_TOPGEN   3392
#define XCD_BAR_WORDS 3456
#define XB_SPIN_CAP (1u << 18)

__device__ __forceinline__ unsigned xb_ld(unsigned* p)              { return __hip_atomic_load(p, __ATOMIC_RELAXED, __HIP_MEMORY_SCOPE_AGENT); }
__device__ __forceinline__ unsigned xb_add(unsigned* p, unsigned v) { return __hip_atomic_fetch_add(p, v, __ATOMIC_RELAXED, __HIP_MEMORY_SCOPE_AGENT); }
__device__ __forceinline__ unsigned xb_xcc_id() { return (unsigned)__builtin_amdgcn_s_getreg((3 << 11) | 20) & 0xFu; }
#define XB_SPIN(cond, bar) do { unsigned _sp = 0; while (cond) { __builtin_amdgcn_s_sleep(1); \
    if ((++_sp & 255u) == 0u) { if (xb_ld(&(bar)[XB_TMO])) break; if (_sp > XB_SPIN_CAP) { atomicAdd(&(bar)[XB_TMO], 1u); break; } } } } while (0)

struct XcdBarrier {
    unsigned* bar; unsigned x;
    volatile LAS unsigned* st;
};

__device__ __forceinline__ XcdBarrier xcd_barrier_post(unsigned* bar, volatile LAS unsigned* st) {
    XcdBarrier b; b.bar = bar; b.x = xb_xcc_id(); b.st = st;
    if (threadIdx.x == 0) (void)xb_add(&bar[XB_XCNT(b.x)], 1u);
    return b;
}
__device__ __forceinline__ void xcd_barrier_complete(unsigned* bar, unsigned x, unsigned& nloc, unsigned& nx) {
    const unsigned G = gridDim.x * gridDim.y * gridDim.z;
    unsigned sum, cnt, mine, sp = 0u;
    for (;;) {
        sum = 0u; cnt = 0u; mine = 0u;
#pragma unroll
        for (unsigned j = 0; j < 16; ++j) { const unsigned c = xb_ld(&bar[XB_XCNT(j)]); sum += c; cnt += (c > 0u) ? 1u : 0u; mine = (j == x) ? c : mine; }
        if (sum == G) break;
        __builtin_amdgcn_s_sleep(1);
        if ((++sp & 255u) == 0u) { if (xb_ld(&bar[XB_TMO])) break; if (sp > XB_SPIN_CAP) { atomicAdd(&bar[XB_TMO], 1u); break; } }
    }
    nloc = mine > 0u ? mine : 1u; nx = cnt > 0u ? cnt : 1u;
}

__device__ __forceinline__ void xcd_barrier(const XcdBarrier& b) {
    asm volatile("s_waitcnt vmcnt(0)" ::: "memory");
    __syncthreads();
    if (threadIdx.x == 0) {
        unsigned* bar = b.bar; const unsigned bx_ = xb_xcc_id();
        __builtin_amdgcn_s_waitcnt(0);
        unsigned nloc = b.st[0], nx = b.st[1];
        if (nloc == 0u) { xcd_barrier_complete(bar, bx_, nloc, nx); b.st[0] = nloc; b.st[1] = nx; }
        const unsigned old = xb_add(&bar[XB_XSUB(bx_)], 1u);
        const unsigned gen = old / nloc;
        if (old + 1u == (gen + 1u) * nloc) {
            __builtin_amdgcn_fence(__ATOMIC_RELEASE, "agent");
            asm volatile("s_waitcnt vmcnt(0)" ::: "memory");
            const unsigned og = xb_add(&bar[XB_TOP], 1u);
            const unsigned tg = og / nx;
            if (og + 1u == (tg + 1u) * nx) xb_add(&bar[XB_TOPGEN], 1u);
            else XB_SPIN(xb_ld(&bar[XB_TOPGEN]) == tg, bar);
            __builtin_amdgcn_fence(__ATOMIC_ACQUIRE, "agent");
            xb_add(&bar[XB_XGEN(bx_)], 1u);
            asm volatile("s_waitcnt vmcnt(0)" ::: "memory");
        } else {
            XB_SPIN(xb_ld(&bar[XB_XGEN(bx_)]) == gen, bar);
            __builtin_amdgcn_fence(__ATOMIC_ACQUIRE, "agent");
            asm volatile("s_waitcnt vmcnt(0)" ::: "memory");
        }
    }
    __syncthreads();
}


__global__ void __launch_bounds__(NTHREADS, 2) fwd_megakernel(Args A) {
    extern __shared__ __attribute__((aligned(16))) unsigned char lds_raw[];
    LAS unsigned char* lds = (LAS unsigned char*)lds_raw;
    cg::grid_group grid = cg::this_grid();
    const int tid = threadIdx.x, lane = tid & 63, wave = __builtin_amdgcn_readfirstlane(tid >> 6);
    const int G = gridDim.x, bx = blockIdx.x, gw = bx * NWAVES + wave, NGW = G * NWAVES;
    unsigned char* ws = A.ws;
    const float* modacc = (const float*)(ws + WS_MODACC);
    bf16_t* HX = (bf16_t*)(ws + WS_HX); bf16_t* U = (bf16_t*)(ws + WS_U); bf16_t* CAT = (bf16_t*)(ws + WS_CAT);
    float* X1 = (float*)(ws + WS_X1); bf16_t* KV = (bf16_t*)(ws + WS_KV); bf16_t* SP = (bf16_t*)(ws + WS_SP);
    volatile LAS unsigned* MISC = (volatile LAS unsigned*)(lds + LDS_BYTES - 256);
    if (tid < 32) MISC[tid] = 0u;
    __syncthreads();
    XcdBarrier xbar = xcd_barrier_post((unsigned*)(ws + WS_CTL), MISC + 8);
#define GRID_BAR() do { xcd_barrier(xbar); } while (0)

#if PH & 1
    phase0(A, lds, tid, lane, wave);
#endif
    if (A.ws == nullptr) grid.sync();
    GRID_BAR();

    for (int l = 0; l < 2; ++l) {
        const float* modx = modacc + (size_t)(l * 2 + 0) * 6144;
        const float* modc = modacc + (size_t)(l * 2 + 1) * 6144;
#if PH & 2
        for (int ra2 = 0; ra2 < REP_A; ++ra2) { if (ra2) GRID_BAR(); const float* nw = A.in[4] + l * D;
          const float* sx = (l == 0) ? A.in[0] : X1;
          const float* sc = (l == 0) ? A.in[2] : X1 + (size_t)SEQ * D;
          norm_mod_rows(sx, SEQ, HX, nw, modx, modx + D, gw, NGW, lane);
          norm_mod_rows(sc, CTXL, HX + (size_t)SEQ * D, nw, modc, modc + D, gw, NGW, lane); }
#endif
        GRID_BAR();
#if PH & 4
        for (int rep_b = 0; rep_b < REP_B; ++rep_b) { const bf16_t* WinT = (const bf16_t*)(ws + WS_WIN) + (size_t)l * 8192 * 2048;
          pg8::Gemm g{HX, WinT, SEQ, DIN, D}; pg8::StaticOrder S; S.init(SEQ, DIN, G, bx);
          pg8::EpiIn E{U, (const float*)(ws + WS_ROPE), A.in[8] + l * 3 * DCONV, A.in[9] + l * DCONV, rep_b ? (bf16_t*)(ws + WS_KV) : CAT, rep_b ? (float*)(ws + WS_SP) : (float*)(ws + WS_ROWSQ) + l * SEQ};
          pg8::gemm_phase<pg8::EpiIn, pg8::StaticOrder, true, true>(lds, g, S, E);
          const int vb = bx & 255;
          (void)vb;
          if (l == 0) { for (int t = bx; t < 256; t += G) ctx_gemm_slab<2, 0>(HX + (size_t)SEQ * D, WinT, (t & 7) * 32, (t >> 3) * 256, tid, wave, lds, U + (size_t)SEQ * DIN, nullptr, nullptr, nullptr); }
          else { if (G > 128 && bx >= 128) convert_weights(A, lds, 1, L1C_C, L1C_D, (bx - 128) * NWAVES + wave, (G - 128) * NWAVES, lane, wave);
                 for (int t = bx; t < 128; t += G) ctx_gemm_slab<1, 0>(HX + (size_t)SEQ * D, WinT, (t & 7) * 32, 5120 + (t >> 3) * 128, tid, wave, lds, U + (size_t)SEQ * DIN, nullptr, nullptr, nullptr); }
          if (rep_b + 1 < REP_B) GRID_BAR(); }
#endif
        GRID_BAR();
        for (int rep_c = 0; rep_c < REP_CDE; ++rep_c) {
#if PH & 8
        for (int rc2 = 0; rc2 < REP_C; ++rc2) { const int nrows = (l == 0) ? MROWS : SEQ;
          { u32x4 kpre[8];
            { const int u0 = bx < NCH * NH ? bx : NCH * NH - 1; kv_tiles_request(U, u0 >> 3, u0 & 7, tid, kpre); }
            const bool same_h = (G & 7) == 0; const int h0 = bx & 7;
            const float l2f0 = -expf(A.in[11][l * NH + h0]) * LOG2E, l2b0 = -expf(A.in[12][l * NH + h0]) * LOG2E;
            for (int u = bx; u < NCH * NH; u += G) { const int n = u >> 3, h = u & 7; const int u2 = u + G;
                const float l2f = same_h ? l2f0 : -expf(A.in[11][l * NH + h]) * LOG2E, l2b = same_h ? l2b0 : -expf(A.in[12][l * NH + h]) * LOG2E;
                kv_unit(U, KV, n, h, l2f, l2b, lds, tid, lane, wave, kpre, u2 < NCH * NH, u2 >> 3, u2 & 7); } }
          { const float* cw = A.in[8] + l * 3 * DCONV; const float* cnw = A.in[9] + l * DCONV; const float* rowsq = (const float*)(ws + WS_ROWSQ) + l * SEQ;
            for (int t0 = 4 * gw; t0 < SEQ; t0 += 4 * NGW) conv_finish_rows(U, CAT, rowsq, cw, cnw, t0, lane);
            if (l == 0) { for (int t = NGW - 1 - gw; t < CTXL; t += NGW) conv_fix_row(U, CAT, cw, cnw, SEQ + t, SEQ, MROWS, lane); }
            if (l == 0) { __syncthreads(); if (G > 16) { if (bx >= 16) mod_gemv(A, lds, 1, bx - 16, G - 16, tid, lane, wave); } else mod_gemv(A, lds, 1, bx, G, tid, lane, wave);
                          if (G > 128 && bx >= 16) convert_weights(A, lds, 1, 0, L1C_A, (bx - 16) * NWAVES + wave, (G - 16) * NWAVES, lane, wave); }
            if (l == 1 && rc2 == 0 && G > 128 && bx >= 16) { __syncthreads(); convert_weights(A, lds, 1, L1C_D, 10240, (bx - 16) * NWAVES + wave, (G - 16) * NWAVES, lane, wave); } }
          if (rc2 + 1 < REP_C) GRID_BAR(); }
#endif
        GRID_BAR();
#if PH & 16
        for (int rd2 = 0; rd2 < REP_D; ++rd2) { if (rd2) GRID_BAR();
        scan_phase(KV, SP, A.in[11] + l * NH, A.in[12] + l * NH, tid); }
#endif
        u32x4 pre[12];
        { const int nchq = (l == 0) ? NCH : 64; const int u0 = bx < nchq * NH ? bx : nchq * NH - 1; ret_tiles_request(U, u0 >> 3, u0 & 7, tid, pre); }
        GRID_BAR();
#if PH & 32
        for (int re2 = 0; re2 < REP_E; ++re2) { const int nch = (l == 0) ? NCH : 64;
          if (re2) { GRID_BAR(); const int u0 = bx < nch * NH ? bx : nch * NH - 1; ret_tiles_request(U, u0 >> 3, u0 & 7, tid, pre); }
          const bool same_h = (G & 7) == 0; const int h0 = bx & 7;
          const float l2f0 = -expf(A.in[11][l * NH + h0]) * LOG2E, l2b0 = -expf(A.in[12][l * NH + h0]) * LOG2E;
          for (int u = bx; u < nch * NH; u += G) { const int n = u >> 3, h = u & 7; const int u2 = u + G; const bool hn = u2 < nch * NH;
              const float l2f = same_h ? l2f0 : -expf(A.in[11][l * NH + h]) * LOG2E, l2b = same_h ? l2b0 : -expf(A.in[12][l * NH + h]) * LOG2E;
              ret_unit<0>(U, SP, CAT, A.in[10] + l * 1024, n, h, l2f, l2b, lds, tid, lane, wave, pre, hn, u2 >> 3, u2 & 7); }
          if (l == 0) { if (G > 128) { if (bx >= 16) convert_weights(A, lds, 1, L1C_A, L1C_B, (bx - 16) * NWAVES + wave, (G - 16) * NWAVES, lane, wave); } else convert_weights(A, lds, 1, 0, 10240, bx * NWAVES + wave, G * NWAVES, lane, wave); } }
#endif
        GRID_BAR();
        }
#if PH & 64
        for (int rf2 = 0; rf2 < (l == 0 ? REP_F0 : 1); ++rf2) { if (rf2) GRID_BAR(); const bf16_t* WoT = (const bf16_t*)(ws + WS_WOUT) + (size_t)l * 2048 * 2048;
          pg8::Gemm g{CAT, WoT, SEQ, D, D}; pg8::StaticOrder S; S.init(SEQ, D, G, bx);
          pg8::EpiRes E{(l == 0) ? A.in[0] : X1, X1, X1, modx + 2 * D, modc + 2 * D};
          pg8::gemm_phase<pg8::EpiRes, pg8::StaticOrder, true, true>(lds, g, S, E);
          if (l == 0 && G > 128 && bx >= 128) convert_weights(A, lds, 1, L1C_B, L1C_C, (bx - 128) * NWAVES + wave, (G - 128) * NWAVES, lane, wave);
          if (l == 0) { for (int t = bx; t < 128; t += G) ctx_gemm_slab<1, 1>(CAT + (size_t)SEQ * D, WoT, (t & 7) * 32, (t >> 3) * 128, tid, wave, lds, nullptr, A.in[2], modc + 2 * D, X1 + (size_t)SEQ * D); } }
#endif
        GRID_BAR();
    }
#ifdef REP_BAR
    for (int rb9 = 0; rb9 < REP_BAR; ++rb9) GRID_BAR();
#endif
#if PH & 128
    final_norm_rows(X1, SEQ, A.out, A.in[14], gw, NGW, lane);
#endif
}

extern "C" void kernel_launch(void* const* d_in, const int* in_sizes, int n_in, void* d_out, int out_size, void* d_ws, size_t ws_size, hipStream_t stream) {
    static int grid = 0;
    if (grid == 0) {
        if (n_in != 15 || ws_size < WS_END) { fprintf(stderr, "kernel_launch: unexpected n_in %d / ws %zu\n", n_in, ws_size); grid = -1; return; }
        int dev = 0, cus = 0, per_cu = 0;
        hipGetDevice(&dev);
        hipDeviceGetAttribute(&cus, hipDeviceAttributeMultiprocessorCount, dev);
        hipFuncSetAttribute((const void*)fwd_megakernel, hipFuncAttributeMaxDynamicSharedMemorySize, LDS_BYTES);
        hipOccupancyMaxActiveBlocksPerMultiprocessor(&per_cu, (const void*)fwd_megakernel, NTHREADS, LDS_BYTES);
        if (per_cu < 1) { fprintf(stderr, "kernel_launch: occupancy query says %d blocks per CU\n", per_cu); per_cu = 1; }
        grid = cus;
        if (grid > 256) grid = 256;
    }
    if (grid < 0) return;
    hipMemsetAsync((char*)d_ws + WS_CTL, 0, CTL_ZERO_BYTES, stream);
    Args a{};
    for (int i = 0; i < 15; ++i) a.in[i] = (const float*)d_in[i];
    a.out = (float*)d_out; a.ws = (unsigned char*)d_ws;
    void* args[] = {&a};
    hipError_t e = hipLaunchCooperativeKernel((const void*)fwd_megakernel, dim3(grid), dim3(NTHREADS), args, LDS_BYTES, stream);
    if (e != hipSuccess) fprintf(stderr, "cooperative launch failed: %s (grid %d)\n", hipGetErrorString(e), grid);
}
```

```cpp
#include <hip/hip_runtime.h>
#include <hip/hip_cooperative_groups.h>
#include <cstdio>
#include <cstdint>
namespace cg = cooperative_groups;
namespace pg8 {
#define PG8_LAS __attribute__((address_space(3)))
typedef unsigned short bf16_t;
typedef short bf16x8 __attribute__((ext_vector_type(8)));
typedef float f32x4 __attribute__((ext_vector_type(4)));
typedef unsigned u32x4 __attribute__((ext_vector_type(4)));
constexpr int BM = 256, BK = 64, HALF = 128, HTB = HALF * BK * 2  , STAGE_BYTES = 8 * HTB, NXCD = 8, WGM = 8;

__host__ __device__ __forceinline__ int lds_byte(int r, int c) { const int st = (r >> 4) * 2 + (c >> 5), rr = r & 15, cc = c & 31, ob = rr * 64 + cc * 2; return st * 1024 + (ob ^ (((ob >> 9) & 1) << 5)); }
__host__ __device__ __forceinline__ void stage_rc(int b, int& R, int& C) { const int st = b / 1024, sb = b % 1024, swz = sb ^ (((sb >> 9) & 1) << 5); R = (st >> 1) * 16 + swz / 64; C = (st & 1) * 32 + (swz % 64) / 2; }
__host__ __device__ __forceinline__ int perm32(int rho) { const int n = rho >> 4, i = rho & 15; return 8 * (i >> 2) + 4 * n + (i & 3); }

struct Unit { int pm, pn; };
struct Gemm { const bf16_t* A; const bf16_t* Bt; int M, N, K; };

struct StaticOrder {
    int nM, nN, nwg, G, c;
    __host__ __device__ void init(int M, int N, int G_, int c_) { nM = M / BM; nN = N / BM; nwg = nM * nN; G = G_; c = c_; }
    __host__ __device__ bool next(int i, Unit& u) const {
        const long L = (long)i * G + c; if (L >= nwg) return false;
        int wgid = (int)L; { const int q = nwg / NXCD, r = nwg % NXCD, xcd = wgid % NXCD, off = wgid / NXCD; wgid = (xcd < r ? xcd * (q + 1) : r * (q + 1) + (xcd - r) * q) + off; }
        const int nig = WGM * nN, gid = wgid / nig, fm = gid * WGM, gsz = (nM - fm) < WGM ? (nM - fm) : WGM;
        u.pm = fm + ((wgid % nig) % gsz); u.pn = (wgid % nig) / gsz; return true;
    }
    __device__ __forceinline__ void a_ready(const Unit&) const {}
    __device__ __forceinline__ void done(const Unit&) const {}
};
__device__ __forceinline__ unsigned cvt_pk_bf16(float lo, float hi) { unsigned r; asm volatile("v_cvt_pk_bf16_f32 %0, %1, %2" : "=v"(r) : "v"(lo), "v"(hi)); return r; }
struct EpiIn {
    static constexpr bool PERM = true, AFTER_DRAIN = false;
    bf16_t* U; const float* rope;
    const float* cw; const float* cnw; bf16_t* CAT; float* rowsq;
    __device__ __forceinline__ void operator()(const f32x4 (&acc)[2][2][4][2], const Unit& u, int wr, int wc, int fr, int fq) const {
        const int row0 = u.pm * BM + wr * 64 + fr;
        const int col0 = u.pn * BM + wc * 32 + 8 * fq;
        if (u.pn < 16) {
            const int ch0 = u.pn * 64 + wc * 16 + fq * 4, lane = 16 * fq + fr;
            const f32x4 w0 = *(const f32x4*)(cw + ch0), w1 = *(const f32x4*)(cw + 1024 + ch0), w2 = *(const f32x4*)(cw + 2048 + ch0), nw = *(const f32x4*)(cnw + ch0);
#pragma unroll
            for (int ai = 0; ai < 2; ++ai) {
                f32x4 g[4];
#pragma unroll
                for (int m = 0; m < 4; ++m) g[m] = acc[ai][0][m][0] * acc[ai][0][m][1];
#pragma unroll
                for (int m = 0; m < 4; ++m) {
                    f32x4 gp, gn;
#pragma unroll
                    for (int j = 0; j < 4; ++j) {
                        const float a = __shfl(g[m][j], lane - 1), aw = (m > 0) ? __shfl(g[m > 0 ? m - 1 : 0][j], lane + 15) : 0.f;
                        const float c = __shfl(g[m][j], lane + 1), cw_ = (m < 3) ? __shfl(g[m < 3 ? m + 1 : 3][j], lane - 15) : 0.f;
                        gp[j] = fr > 0 ? a : aw; gn[j] = fr < 15 ? c : cw_; }
                    const bool valid = !((m == 0 && fr == 0) || (m == 3 && fr == 15));
                    const bool edge = (m == 0 && fr < 2) || (m == 3 && fr >= 14);
                    const int row = row0 + ai * HALF + m * 16;
                    const f32x4 bq = acc[ai][1][m][0], zq = acc[ai][1][m][1];
                    const f32x4 y = bq * (w0 * gp + w1 * g[m] + w2 * gn);
                    float ss = (y[0] * y[0] + y[1] * y[1]) + (y[2] * y[2] + y[3] * y[3]);
                    ss += __shfl_xor(ss, 16); ss += __shfl_xor(ss, 32);
                    if (valid) {
                        if (fq == 0) atomicAdd(rowsq + row, ss);
                        f32x4 o;
#pragma unroll
                        for (int j = 0; j < 4; ++j) o[j] = zq[j] * __builtin_amdgcn_rcpf(1.f + __builtin_amdgcn_exp2f(-1.4426950408889634f * zq[j])) * y[j] * nw[j];
                        unsigned lo = cvt_pk_bf16(o[0], o[1]), hi = cvt_pk_bf16(o[2], o[3]);
                        unsigned long long w = (unsigned long long)lo | ((unsigned long long)hi << 32);
                        *(unsigned long long*)(CAT + (size_t)row * 2048 + ch0) = w; }
                    if (edge) {
                        bf16_t* rowp = U + (size_t)row * 8192 + col0;
#pragma unroll
                        for (int bj = 0; bj < 2; ++bj) { const f32x4 v0 = acc[ai][bj][m][0] * 1.f, v1 = acc[ai][bj][m][1] * 1.f;
                            u32x4 w; w.x = cvt_pk_bf16(v0[0], v0[1]); w.y = cvt_pk_bf16(v0[2], v0[3]); w.z = cvt_pk_bf16(v1[0], v1[1]); w.w = cvt_pk_bf16(v1[2], v1[3]);
                            *(u32x4*)(rowp + bj * HALF) = w; } }
                }
            }
            return;
        }
        const int kind = u.pn >> 2;
        const float sc = (kind == 5) ? 0.08838834764831845f : 1.f;
        const bool dorope = (kind == 4 || kind == 5) && (u.pm < 32);
        const int fi = (wc & 1) * 16 + fq * 4;
#pragma unroll
        for (int ai = 0; ai < 2; ++ai)
#pragma unroll
            for (int m = 0; m < 4; ++m) {
                const int row = row0 + ai * HALF + m * 16;
                bf16_t* rowp = U + (size_t)row * 8192 + col0;
                f32x4 cs = (f32x4){1.f, 1.f, 1.f, 1.f}, sn = (f32x4){0.f, 0.f, 0.f, 0.f};
                if (dorope) { const int pos = (wc < 2) ? (row >> 6) : (row & 63); cs = *(const f32x4*)(rope + pos * 32 + fi); sn = *(const f32x4*)(rope + 4096 + pos * 32 + fi); }
#pragma unroll
                for (int bj = 0; bj < 2; ++bj) {
                    f32x4 v0 = acc[ai][bj][m][0], v1 = acc[ai][bj][m][1];
                    const f32x4 a = (v0 * cs - v1 * sn) * sc, b = (v0 * sn + v1 * cs) * sc;
                    u32x4 w; w.x = cvt_pk_bf16(a[0], a[1]); w.y = cvt_pk_bf16(a[2], a[3]); w.z = cvt_pk_bf16(b[0], b[1]); w.w = cvt_pk_bf16(b[2], b[3]);
                    *(u32x4*)(rowp + bj * HALF) = w; }
            }
    }
};
struct EpiRes {
    static constexpr bool PERM = false, AFTER_DRAIN = false;
    const float* rx; const float* rc; float* out; const float* gx; const float* gc;
    __device__ __forceinline__ void operator()(const f32x4 (&acc)[2][2][4][2], const Unit& u, int wr, int wc, int fr, int fq) const {
        const int row0 = u.pm * BM + wr * 64 + fr, col0 = u.pn * BM + wc * 32 + 4 * fq;
        const bool isctx = u.pm >= 32;
        const float* g = isctx ? gc : gx;
        f32x4 gv[2][2];
#pragma unroll
        for (int bj = 0; bj < 2; ++bj)
#pragma unroll
            for (int n = 0; n < 2; ++n) gv[bj][n] = *(const f32x4*)(g + col0 + bj * HALF + n * 16);
        f32x4 r[2][2][2][2];
#define ER_LOAD(buf, b) do { const int ai_ = (b) >> 1, mp_ = ((b) & 1) * 2; _Pragma("unroll") for (int mm = 0; mm < 2; ++mm) { const int row = row0 + ai_ * HALF + (mp_ + mm) * 16; \
            const float* rp = (isctx ? rc + (size_t)(row - 8192) * 2048 : rx + (size_t)row * 2048) + col0; \
            _Pragma("unroll") for (int bj = 0; bj < 2; ++bj) _Pragma("unroll") for (int n = 0; n < 2; ++n) r[buf][mm][bj][n] = __builtin_nontemporal_load((const f32x4*)(rp + bj * HALF + n * 16)); } } while (0)
        ER_LOAD(0, 0);
#pragma unroll
        for (int b = 0; b < 4; ++b) {
            if (b + 1 < 4) { if (b & 1) ER_LOAD(0, b + 1); else ER_LOAD(1, b + 1); }
            __builtin_amdgcn_sched_barrier(0);
            const int ai = b >> 1, mp = (b & 1) * 2;
#pragma unroll
            for (int mm = 0; mm < 2; ++mm) {
                const int row = row0 + ai * HALF + (mp + mm) * 16;
                float* op = out + (size_t)row * 2048 + col0;
#pragma unroll
                for (int bj = 0; bj < 2; ++bj)
#pragma unroll
                    for (int n = 0; n < 2; ++n) *(f32x4*)(op + bj * HALF + n * 16) = r[b & 1][mm][bj][n] + gv[bj][n] * acc[ai][bj][mp + mm][n];
            }
            __builtin_amdgcn_sched_barrier(0);
        }
#undef ER_LOAD
    }
};
template <class Epi, class Sched, bool ALIGN_EPI = false, bool SP2 = false>
__device__ __forceinline__ void gemm_phase(PG8_LAS unsigned char* lds, const Gemm g, const Sched& S, const Epi& E) {
    int tid_ = threadIdx.x; asm volatile("" : "+v"(tid_));
    const int tid = tid_, wid = __builtin_amdgcn_readfirstlane(tid >> 6), lane = tid & 63, wr = wid >> 2, wc = wid & 3, fr = lane & 15, fq = lane >> 4;
    const int K = g.K, nt = K / BK;
    unsigned voffA[2], voffB[2];
#pragma unroll
    for (int i = 0; i < 2; ++i) { int R, C; stage_rc(tid * 16 + i * 8192, R, C); const int Rb = Epi::PERM ? ((R & ~31) + perm32(R & 31)) : R;
        voffA[i] = (unsigned)(R * K + C) * 2u; voffB[i] = (unsigned)(Rb * K + C) * 2u; }
    const size_t kstep = (size_t)(BK * 2);
    const size_t hstep = (size_t)HALF * K * 2;
    const size_t tstep = 2 * hstep;
    const unsigned ldsw = (unsigned)wid * 1024u;
    const int aoff = lds_byte(wr * 64 + fr, fq * 8), boff = lds_byte(wc * 32 + fr, fq * 8);
#define PG8_SA(b, h) (((b) * 2 + (h)) * HTB)
#define PG8_SB(b, h) ((4 + (b) * 2 + (h)) * HTB)
#define PG8_STAGE(bufoff, gbase, voff) do { _Pragma("unroll") for (int _i = 0; _i < 2; ++_i) \
        __builtin_amdgcn_global_load_lds((const unsigned*)((const char*)(gbase) + (voff)[_i]), (PG8_LAS unsigned*)(lds + (bufoff) + ldsw + _i * 8192), 16, 0, 0); } while (0)
#define PG8_LDA(dst, b, h) do { _Pragma("unroll") for (int m = 0; m < 4; ++m) _Pragma("unroll") for (int k = 0; k < 2; ++k) dst[m][k] = *(const PG8_LAS bf16x8*)(lds + PG8_SA(b, h) + aoff + m * 2048 + k * 1024); } while (0)
#define PG8_LDB(dst, b, h) do { _Pragma("unroll") for (int n = 0; n < 2; ++n) _Pragma("unroll") for (int k = 0; k < 2; ++k) dst[n][k] = *(const PG8_LAS bf16x8*)(lds + PG8_SB(b, h) + boff + n * 2048 + k * 1024); } while (0)
#define PG8_MMA(ai, bj, At, Bt) do { __builtin_amdgcn_s_setprio(1); _Pragma("unroll") for (int m = 0; m < 4; ++m) _Pragma("unroll") for (int n = 0; n < 2; ++n) _Pragma("unroll") for (int k = 0; k < 2; ++k) \
        acc[ai][bj][m][n] = __builtin_amdgcn_mfma_f32_16x16x32_bf16(Bt[n][k], At[m][k], acc[ai][bj][m][n], 0, 0, 0); __builtin_amdgcn_s_setprio(0); } while (0)
#define PG8_WAIT_V(n) asm volatile("s_waitcnt vmcnt(" #n ")" ::: "memory")
#define PG8_WAIT_L(n) asm volatile("s_waitcnt lgkmcnt(" #n ")" ::: "memory")
#define PG8_BAR __builtin_amdgcn_s_barrier()
#define PG8_SCHED __builtin_amdgcn_sched_barrier(0)
    Unit cur, nxt; int ui = 0;
    if (!S.next(0, cur)) return;
    f32x4 acc[2][2][4][2];
#pragma unroll
    for (int a = 0; a < 2; ++a)
#pragma unroll
        for (int b = 0; b < 2; ++b)
#pragma unroll
            for (int m = 0; m < 4; ++m)
#pragma unroll
                for (int n = 0; n < 2; ++n) acc[a][b][m][n] = (f32x4){0.f, 0.f, 0.f, 0.f};
    bf16x8 At[4][2], B0[2][2], B1[2][2];
    const char* cA = (const char*)g.A + (size_t)cur.pm * tstep; const char* cB = (const char*)g.Bt + (size_t)cur.pn * tstep;
    S.a_ready(cur);
    if constexpr (SP2) {
        PG8_STAGE(PG8_SB(0, 0), cB, voffB); PG8_STAGE(PG8_SB(0, 1), cB + hstep, voffB); PG8_STAGE(PG8_SA(0, 0), cA, voffA); PG8_STAGE(PG8_SA(0, 1), cA + hstep, voffA);
        if (wr == 1) PG8_BAR;
        PG8_WAIT_V(2); PG8_BAR;
        PG8_STAGE(PG8_SB(1, 0), cB + kstep, voffB); PG8_STAGE(PG8_SA(1, 0), cA + kstep, voffA); PG8_STAGE(PG8_SB(1, 1), cB + hstep + kstep, voffB);
        PG8_WAIT_V(6); PG8_BAR;
    } else {
        PG8_STAGE(PG8_SB(0, 0), cB, voffB); PG8_STAGE(PG8_SA(0, 0), cA, voffA); PG8_STAGE(PG8_SB(0, 1), cB + hstep, voffB); PG8_STAGE(PG8_SA(0, 1), cA + hstep, voffA);
        if (wr == 1) PG8_BAR;
        PG8_WAIT_V(4); PG8_BAR;
        PG8_STAGE(PG8_SB(1, 0), cB + kstep, voffB); PG8_STAGE(PG8_SA(1, 0), cA + kstep, voffA); PG8_STAGE(PG8_SB(1, 1), cB + hstep + kstep, voffB);
        PG8_WAIT_V(6); PG8_BAR;
    }
    for (;;) {
        const bool has_next = S.next(ui + 1, nxt);
        const char* nA = has_next ? (const char*)g.A + (size_t)nxt.pm * tstep : cA; const char* nB = has_next ? (const char*)g.Bt + (size_t)nxt.pn * tstep : cB;
        for (int t = 0; t < nt; t += 2) {
            const bool last = (t == nt - 2);
            const char* a1 = cA + (size_t)(t + 1) * kstep;
            const char* a2 = last ? nA : cA + (size_t)(t + 2) * kstep; const char* b2 = last ? nB : cB + (size_t)(t + 2) * kstep;
            const char* a3 = a2 + kstep; const char* b3 = b2 + kstep;
            if (last && has_next) S.a_ready(nxt);
            if constexpr (SP2) {
            PG8_LDB(B0, 0, 0); PG8_LDB(B1, 0, 1); PG8_SCHED; PG8_LDA(At, 0, 0); PG8_STAGE(PG8_SA(1, 1), a1 + hstep, voffA);
            PG8_WAIT_V(8); PG8_WAIT_L(0); PG8_BAR; PG8_MMA(0, 0, At, B0); PG8_MMA(0, 1, At, B1); PG8_BAR; PG8_SCHED;
            PG8_LDA(At, 0, 1); PG8_STAGE(PG8_SB(0, 0), b2, voffB); PG8_STAGE(PG8_SB(0, 1), b2 + hstep, voffB); PG8_STAGE(PG8_SA(0, 0), a2, voffA);
            PG8_WAIT_V(8); PG8_WAIT_L(0); PG8_BAR; PG8_MMA(1, 0, At, B0); PG8_MMA(1, 1, At, B1); PG8_BAR; PG8_SCHED;
            PG8_LDB(B0, 1, 0); PG8_LDB(B1, 1, 1); PG8_SCHED; PG8_LDA(At, 1, 0); PG8_STAGE(PG8_SA(0, 1), a2 + hstep, voffA);
            PG8_WAIT_V(8); PG8_WAIT_L(0); PG8_BAR; PG8_MMA(0, 0, At, B0); PG8_MMA(0, 1, At, B1); PG8_BAR; PG8_SCHED;
            PG8_LDA(At, 1, 1); PG8_STAGE(PG8_SB(1, 0), b3, voffB); PG8_STAGE(PG8_SB(1, 1), b3 + hstep, voffB); PG8_STAGE(PG8_SA(1, 0), a3, voffA);
            PG8_WAIT_V(8); PG8_WAIT_L(0); PG8_BAR; PG8_MMA(1, 0, At, B0); PG8_MMA(1, 1, At, B1); PG8_BAR; PG8_SCHED;
            } else {
            PG8_LDB(B0, 0, 0); PG8_SCHED; PG8_LDA(At, 0, 0); PG8_STAGE(PG8_SA(1, 1), a1 + hstep, voffA);
            PG8_WAIT_L(8); PG8_BAR; PG8_WAIT_L(0); PG8_MMA(0, 0, At, B0); PG8_BAR; PG8_SCHED;
            PG8_LDB(B1, 0, 1); PG8_STAGE(PG8_SB(0, 0), b2, voffB);
            PG8_BAR; PG8_WAIT_L(0); PG8_MMA(0, 1, At, B1); PG8_BAR;
            PG8_LDA(At, 0, 1); PG8_STAGE(PG8_SA(0, 0), a2, voffA);
            PG8_BAR; PG8_WAIT_L(0); PG8_MMA(1, 0, At, B0); PG8_BAR; PG8_SCHED;
            PG8_STAGE(PG8_SB(0, 1), b2 + hstep, voffB);
            PG8_WAIT_V(6); PG8_BAR; PG8_MMA(1, 1, At, B1); PG8_BAR;
            PG8_LDB(B0, 1, 0); PG8_SCHED; PG8_LDA(At, 1, 0); PG8_STAGE(PG8_SA(0, 1), a2 + hstep, voffA);
            PG8_WAIT_L(8); PG8_BAR; PG8_WAIT_L(0); PG8_MMA(0, 0, At, B0); PG8_BAR; PG8_SCHED;
            PG8_LDB(B1, 1, 1); PG8_STAGE(PG8_SB(1, 0), b3, voffB);
            PG8_BAR; PG8_WAIT_L(0); PG8_MMA(0, 1, At, B1); PG8_BAR;
            PG8_LDA(At, 1, 1); PG8_STAGE(PG8_SA(1, 0), a3, voffA);
            PG8_BAR; PG8_WAIT_L(0); PG8_MMA(1, 0, At, B0); PG8_BAR; PG8_SCHED;
            PG8_STAGE(PG8_SB(1, 1), b3 + hstep, voffB);
            PG8_WAIT_V(6); PG8_BAR; PG8_MMA(1, 1, At, B1); PG8_BAR;
            }
        }
        if constexpr (ALIGN_EPI) { if (wr == 0) PG8_BAR; }
        if constexpr (!Epi::AFTER_DRAIN) { E(acc, cur, wr, wc, fr, fq); S.done(cur); }
        if (!has_next) break;
#pragma unroll
        for (int a = 0; a < 2; ++a)
#pragma unroll
            for (int b = 0; b < 2; ++b)
#pragma unroll
                for (int m = 0; m < 4; ++m)
#pragma unroll
                    for (int n = 0; n < 2; ++n) acc[a][b][m][n] = (f32x4){0.f, 0.f, 0.f, 0.f};
        cur = nxt; cA = nA; cB = nB; ++ui;
        if constexpr (ALIGN_EPI) { if (wr == 1) PG8_BAR; }
    }
    PG8_WAIT_V(0);
    if constexpr (!ALIGN_EPI) { if (wr == 0) PG8_BAR; }
    PG8_BAR;
    if constexpr (Epi::AFTER_DRAIN) { E.fused(acc, cur, wr, wc, fr, fq, lds, wid, lane); S.done(cur); }
#undef PG8_SA
#undef PG8_SB
#undef PG8_STAGE
#undef PG8_LDA
#undef PG8_LDB
#undef PG8_MMA
#undef PG8_WAIT_V
#undef PG8_WAIT_L
#undef PG8_BAR
#undef PG8_SCHED
}
}

#ifndef PH
#define PH 255
#endif
#ifndef REP_B
#define REP_B 1
#endif
#ifndef REP_CDE
#define REP_CDE 1
#endif
#ifndef REP_T
#define REP_T 1
#endif
#ifndef REP_C
#define REP_C 1
#endif
#ifndef REP_D
#define REP_D 1
#endif
#ifndef REP_E
#define REP_E 1
#endif
#ifndef REP_A
#define REP_A 1
#endif
#ifndef REP_F0
#define REP_F0 1
#endif
#define LAS __attribute__((address_space(3)))
typedef unsigned short bf16_t;
typedef short bf16x8 __attribute__((ext_vector_type(8)));
typedef short s16x4 __attribute__((ext_vector_type(4)));
typedef float f32x4 __attribute__((ext_vector_type(4)));
typedef unsigned u32x4 __attribute__((ext_vector_type(4)));
typedef unsigned u32x2 __attribute__((ext_vector_type(2)));

constexpr int D = 2048, SEQ = 8192, CTXL = 256, MROWS = SEQ + CTXL, DIN = 8192, DCONV = 1024, NH = 8, DH = 128, NCH = MROWS / 128  ;
constexpr float EPS = 1e-6f;
constexpr float LOG2E = 1.4426950408889634f;
constexpr int NTHREADS = 512, NWAVES = 8;
constexpr int L1C_A = 1920, L1C_B = 8840;
constexpr int LDS_BYTES = 147456;

constexpr size_t MiB = 1u << 20;
constexpr size_t WS_CTL = 0, CTL_ZERO_BYTES = 1 * MiB;
constexpr size_t WS_ROWSQ = 262144;
constexpr size_t WS_MODACC = 65536;
constexpr size_t WS_ROPE = 1 * MiB;
constexpr size_t WS_WIN = 2 * MiB;
constexpr size_t WS_WOUT = 66 * MiB;
constexpr size_t WS_HX = 82 * MiB;
constexpr size_t WS_U = 115 * MiB;
constexpr size_t WS_CAT = 247 * MiB;
constexpr size_t WS_X1 = 280 * MiB;
constexpr size_t WS_KV = 346 * MiB;
constexpr size_t WS_SP = 412 * MiB;
constexpr size_t WS_END = 445 * MiB;

struct Args { const float* in[15]; float* out; unsigned char* ws; };

#define LDS_WAIT() asm volatile("s_waitcnt lgkmcnt(0)" ::: "memory")
__device__ __forceinline__ unsigned cvt_pk(float lo, float hi) { unsigned r; asm volatile("v_cvt_pk_bf16_f32 %0, %1, %2" : "=v"(r) : "v"(lo), "v"(hi)); return r; }
__device__ __forceinline__ float bflo(unsigned u) { return __uint_as_float(u << 16); }
__device__ __forceinline__ float bfhi(unsigned u) { return __uint_as_float(u & 0xffff0000u); }
__device__ __forceinline__ float wave_sum(float v) {
#pragma unroll
    for (int o = 1; o < 64; o <<= 1) v += __shfl_xor(v, o);
    return v;
}
__device__ __forceinline__ float fexp2(float x) { return __builtin_amdgcn_exp2f(x); }
__device__ __forceinline__ float frsq(float x) { return __builtin_amdgcn_rsqf(x); }
__device__ __forceinline__ float silu_f(float z) { return z * __builtin_amdgcn_rcpf(1.f + __builtin_amdgcn_exp2f(-1.4426950408889634f * z)); }

__device__ __forceinline__ int conv_slot_of_col(int s) { const int Q = s >> 10, ch = s & 1023, pn = ch >> 6, r = ch & 63; return 256 * pn + 128 * (Q & 1) + 32 * (r >> 4) + 8 * ((r >> 2) & 3) + 4 * (Q >> 1) + (r & 3); }
__device__ __forceinline__ int qk_slot_of_dim(int d) { const int half = d >> 6, n = (d >> 5) & 1, f = d & 31; return 32 * (2 * half + (f >> 4)) + 8 * ((f >> 2) & 3) + 4 * n + (f & 3); }

__device__ __forceinline__ void transpose_item(const float* __restrict__ W, int K, int N, bf16_t* __restrict__ WT, LAS float* scr, int item, int lane, bool permqk) {
    const int nblk = N / 32, kb = item / nblk, nb = item % nblk, k0 = 64 * kb, n0 = 32 * nb;
#pragma unroll 8
    for (int i = 0; i < 32; ++i) { const int kk = 2 * i + (lane >> 5); scr[kk * 33 + (lane & 31)] = W[(size_t)(k0 + kk) * N + n0 + (lane & 31)]; }
    LDS_WAIT(); asm volatile("" ::: "memory");
    const int c = lane & 7;
#pragma unroll
    for (int j = 0; j < 4; ++j) { const int n = (lane >> 3) + 8 * j; const LAS float* s = scr + (8 * c) * 33 + n;
        u32x4 o; o.x = cvt_pk(s[0 * 33], s[1 * 33]); o.y = cvt_pk(s[2 * 33], s[3 * 33]); o.z = cvt_pk(s[4 * 33], s[5 * 33]); o.w = cvt_pk(s[6 * 33], s[7 * 33]);
        int dst = n0 + n;
        if (permqk && dst >= 4096 && dst < 6144) dst = (dst & ~127) + qk_slot_of_dim(dst & 127);
        *(u32x4*)(WT + (size_t)dst * K + k0 + 8 * c) = o; }
    LDS_WAIT(); asm volatile("" ::: "memory");
}

__device__ __forceinline__ void my_sincos(double a, double& s, double& c) {
    const double n = rint(a * 0.63661977236758134308);
    double r = fma(-n, 1.57079632679489655800, a); r = fma(-n, 6.12323399573676603587e-17, r);
    const double r2 = r * r;
    double ps = 1.0 / 6227020800.0; ps = ps * r2 - 1.0 / 39916800.0; ps = ps * r2 + 1.0 / 362880.0; ps = ps * r2 - 1.0 / 5040.0; ps = ps * r2 + 1.0 / 120.0; ps = ps * r2 - 1.0 / 6.0; ps = ps * r2 + 1.0; ps *= r;
    double pc = -1.0 / 87178291200.0; pc = pc * r2 + 1.0 / 479001600.0; pc = pc * r2 - 1.0 / 3628800.0; pc = pc * r2 + 1.0 / 40320.0; pc = pc * r2 - 1.0 / 720.0; pc = pc * r2 + 1.0 / 24.0; pc = pc * r2 - 0.5; pc = pc * r2 + 1.0;
    const int q = ((int)n) & 3;
    s = (q == 0) ? ps : (q == 1) ? pc : (q == 2) ? -ps : -pc;
    c = (q == 0) ? pc : (q == 1) ? -ps : (q == 2) ? -pc : ps;
}

__device__ __forceinline__ void mod_gemv(const Args& A, LAS unsigned char* lds, int layer, int vb_, int nvb_, int tid, int lane, int wave) {
    asm volatile("" : "+v"(tid)); lane = tid & 63;
    unsigned char* ws = A.ws; const int it0 = layer * 192;
    { const float* cvec = A.in[1]; const float* cctx = A.in[3]; const float* wmod = A.in[5]; const float* bmod = A.in[6];
      float* modacc = (float*)(ws + WS_MODACC);
      LAS float* red = (LAS float*)lds;
      for (int it = it0 + vb_; it < it0 + 192; it += nvb_) {
          const int l = it / 192, r = it % 192, strip = r / 16, kb = r % 16;
          const float* Wm = wmod + (size_t)l * 2048 * 6144 + strip * 512 + lane * 4;
          f32x4 a1[2], a2[2];
          a1[0] = a1[1] = a2[0] = a2[1] = (f32x4){0.f, 0.f, 0.f, 0.f};
#pragma unroll
          for (int rr = 0; rr < 16; ++rr) { const int k = kb * 128 + wave * 16 + rr;
              const float s1 = silu_f(cvec[k]), s2 = silu_f(cctx[k]);
#pragma unroll
              for (int p = 0; p < 2; ++p) { const f32x4 w = __builtin_nontemporal_load((const f32x4*)(Wm + (size_t)k * 6144 + p * 256)); a1[p] += w * s1; a2[p] += w * s2; } }
#pragma unroll
          for (int p = 0; p < 2; ++p) { *(LAS f32x4*)(red + (wave * 2 + 0) * 512 + p * 256 + lane * 4) = a1[p]; *(LAS f32x4*)(red + (wave * 2 + 1) * 512 + p * 256 + lane * 4) = a2[p]; }
          __syncthreads();
#pragma unroll
          for (int vec = 0; vec < 2; ++vec) { float s = 0.f;
#pragma unroll
              for (int w = 0; w < 8; ++w) s += red[(w * 2 + vec) * 512 + tid];
              if (kb == 0) s += bmod[l * 6144 + strip * 512 + tid];
              atomicAdd(modacc + (size_t)(l * 2 + vec) * 6144 + strip * 512 + tid, s); }
          __syncthreads();
      } }
}

__device__ __forceinline__ void convert_weights(const Args& A, LAS unsigned char* lds, int l, int it_begin, int it_end, int vw, int nvw, int lane, int wave) {
    asm volatile("" : "+v"(lane));
    unsigned char* ws = A.ws;
    LAS float* scr = (LAS float*)(lds + wave * 16384);
    constexpr int I_IN = (2048 / 64) * (8192 / 32), I_OUT = (2048 / 64) * (2048 / 32); const int NIT = it_end;
    const float* w_in = A.in[7] + (size_t)l * 2048 * 8192; const float* w_out = A.in[13] + (size_t)l * 2048 * 2048;
    bf16_t* WinT = (bf16_t*)(ws + WS_WIN) + (size_t)l * 8192 * 2048; bf16_t* WoT = (bf16_t*)(ws + WS_WOUT) + (size_t)l * 2048 * 2048;
#define T_DECODE(it, W, N, WT, perm, k0, n0) do { int r_ = (it); if (r_ < I_IN) { W = w_in; N = 8192; WT = WinT; perm = true; } else { r_ -= I_IN; W = w_out; N = 2048; WT = WoT; perm = false; } \
        const int nblk_ = N / 32; k0 = 64 * (r_ / nblk_); n0 = 32 * (r_ % nblk_); } while (0)
    for (int rep_t = 0; rep_t < REP_T; ++rep_t) {
    int it = it_begin + vw;
    float cur[32], nx1[32];
#define T_LOADS(dst, item) do { const int ic_ = (item) < NIT ? (item) : NIT - 1; const float* W_; int N_, k_, n_; bf16_t* WT_; bool p_; T_DECODE(ic_, W_, N_, WT_, p_, k_, n_); (void)WT_; (void)p_; \
        _Pragma("unroll") for (int i = 0; i < 32; ++i) dst[i] = __builtin_nontemporal_load(W_ + (size_t)(k_ + 2 * i + (lane >> 5)) * N_ + n_ + (lane & 31)); } while (0)
#define T_PROCESS(buf, item) do { const float* W; int N, k0, n0; bf16_t* WT; bool perm; T_DECODE(item, W, N, WT, perm, k0, n0); (void)W; \
        _Pragma("unroll") for (int i = 0; i < 32; ++i) scr[(2 * i + (lane >> 5)) * 33 + (lane & 31)] = buf[i]; \
        T_LOADS(buf, (item) + 2 * nvw); \
        __builtin_amdgcn_sched_barrier(0); \
        LDS_WAIT(); asm volatile("" ::: "memory"); \
        const int c = lane & 7; \
        _Pragma("unroll") for (int j = 0; j < 4; ++j) { const int n = (lane >> 3) + 8 * j; const LAS float* s = scr + (8 * c) * 33 + n; \
            u32x4 o; o.x = cvt_pk(s[0 * 33], s[1 * 33]); o.y = cvt_pk(s[2 * 33], s[3 * 33]); o.z = cvt_pk(s[4 * 33], s[5 * 33]); o.w = cvt_pk(s[6 * 33], s[7 * 33]); \
            int dst = n0 + n; \
            if (perm) { if (dst < 4096) dst = conv_slot_of_col(dst); else if (dst < 6144) dst = (dst & ~127) + qk_slot_of_dim(dst & 127); } \
            *(u32x4*)(WT + (size_t)dst * 2048 + k0 + 8 * c) = o; } \
        LDS_WAIT(); asm volatile("" ::: "memory"); } while (0)
    T_LOADS(cur, it); T_LOADS(nx1, it + nvw);
    while (it < NIT) {
        T_PROCESS(cur, it);
        it += nvw; if (it >= NIT) break;
        T_PROCESS(nx1, it);
        it += nvw;
    } }
#undef T_PROCESS
#undef T_LOADS
#undef T_DECODE
}

__device__ __forceinline__ void phase0(const Args& A, LAS unsigned char* lds, int tid, int lane, int wave) {
    unsigned char* ws = A.ws;
    const int G = gridDim.x, bx = blockIdx.x;
    { const int t = bx * NTHREADS + tid;
      if (t < 4096) { const int pos = t >> 5, fi = t & 31; double inv = 1.0; for (int i = 0; i < fi; ++i) inv *= 0.74989420933245582730;
          double s, c; my_sincos((double)pos * inv, s, c); float* rp = (float*)(ws + WS_ROPE); rp[t] = (float)c; rp[4096 + t] = (float)s; } }
    mod_gemv(A, lds, 0, bx, G, tid, lane, wave);
    convert_weights(A, lds, 0, 0, 10240, bx * NWAVES + wave, G * NWAVES, lane, wave);
}

__device__ __forceinline__ void norm_mod_rows(const float* __restrict__ src, int nrows, bf16_t* __restrict__ dst, const float* __restrict__ nw, const float* __restrict__ shift, const float* __restrict__ scale, int gw, int NGW, int lane) {
    if (gw >= nrows) return;
    asm volatile("" : "+v"(lane));
    f32x4 ca[8], cb[8];
#pragma unroll
    for (int j = 0; j < 8; ++j) { const int c = 4 * lane + 256 * j; const f32x4 w = *(const f32x4*)(nw + c), sc = *(const f32x4*)(scale + c); ca[j] = w * (sc + 1.f); cb[j] = *(const f32x4*)(shift + c); }
    f32x4 nx[8];
    { const f32x4* xr = (const f32x4*)(src + (size_t)gw * D) + lane;
#pragma unroll
      for (int j = 0; j < 8; ++j) nx[j] = __builtin_nontemporal_load(xr + 64 * j); }
    for (int m = gw; m < nrows; m += NGW) {
        f32x4 v[8]; float s = 0.f;
#pragma unroll
        for (int j = 0; j < 8; ++j) { v[j] = nx[j]; s += (v[j].x * v[j].x + v[j].y * v[j].y) + (v[j].z * v[j].z + v[j].w * v[j].w); }
        { const int m2 = (m + NGW < nrows) ? m + NGW : m; const f32x4* xr = (const f32x4*)(src + (size_t)m2 * D) + lane;
#pragma unroll
          for (int j = 0; j < 8; ++j) nx[j] = __builtin_nontemporal_load(xr + 64 * j); }
        __builtin_amdgcn_sched_barrier(0);
        const float rstd = frsq(wave_sum(s) * (1.f / D) + EPS);
        u32x2* o8 = (u32x2*)(dst + (size_t)m * D) + lane;
#pragma unroll
        for (int j = 0; j < 8; ++j) { const f32x4 y = v[j] * rstd * ca[j] + cb[j]; u32x2 w; w.x = cvt_pk(y.x, y.y); w.y = cvt_pk(y.z, y.w); o8[64 * j] = w; }
    }
}
__device__ __forceinline__ void final_norm_rows(const float* __restrict__ src, int nrows, float* __restrict__ dst, const float* __restrict__ nw, int gw, int NGW, int lane) {
    f32x4 ca[8];
#pragma unroll
    for (int j = 0; j < 8; ++j) ca[j] = *(const f32x4*)(nw + 4 * lane + 256 * j);
    if (gw >= nrows) return;
    f32x4 nx[8];
    { const f32x4* xr = (const f32x4*)(src + (size_t)gw * D) + lane;
#pragma unroll
      for (int j = 0; j < 8; ++j) nx[j] = __builtin_nontemporal_load(xr + 64 * j); }
    for (int m = gw; m < nrows; m += NGW) {
        f32x4 v[8]; float s = 0.f;
#pragma unroll
        for (int j = 0; j < 8; ++j) { v[j] = nx[j]; s += (v[j].x * v[j].x + v[j].y * v[j].y) + (v[j].z * v[j].z + v[j].w * v[j].w); }
        { const int m2 = (m + NGW < nrows) ? m + NGW : m; const f32x4* xr = (const f32x4*)(src + (size_t)m2 * D) + lane;
#pragma unroll
          for (int j = 0; j < 8; ++j) nx[j] = __builtin_nontemporal_load(xr + 64 * j); }
        __builtin_amdgcn_sched_barrier(0);
        const float rstd = frsq(wave_sum(s) * (1.f / D) + EPS);
        f32x4* o = (f32x4*)(dst + (size_t)m * D) + lane;
#pragma unroll
        for (int j = 0; j < 8; ++j) o[64 * j] = v[j] * rstd * ca[j];
    }
}

__device__ __forceinline__ unsigned off_b(unsigned row, unsigned ch) { return 256u * row + 16u * (ch ^ (((row & 3) << 2) | ((row >> 2) & 3))); }
__device__ __forceinline__ unsigned rbase_of(int lane) { const unsigned li = lane & 15, g = lane >> 4; return 256u * li + 16u * (((li & 3) << 2) | (g ^ (li >> 2))); }
__device__ __forceinline__ unsigned tbase_of(int lane) { const unsigned g = lane >> 4, q = (lane & 15) >> 2, p = lane & 3; return 256u * (8 * g + q) + 16u * (((q << 2) | (2 * (g & 1))) ^ (p >> 1)) + 8u * (p & 1); }
__device__ __forceinline__ unsigned pbase_of(int lane) { const unsigned g = lane >> 4, q = (lane & 15) >> 2, p = lane & 3; return 256u * (4 * g + q) + 16u * (((q << 2) | g) ^ (p >> 1)) + 8u * (p & 1); }
__device__ __forceinline__ bf16x8 rowfrag(LAS const unsigned char* tile, unsigned rbase, int rb, int s) { return *(LAS const bf16x8*)(tile + (rbase ^ (unsigned)(s << 6)) + rb * 4096); }
__device__ __forceinline__ bf16x8 trfrag(LAS const unsigned char* tile, unsigned tbase, int c, int ks) {
    const s16x4 lo = __builtin_amdgcn_ds_read_tr16_b64_v4i16((LAS s16x4*)(tile + (tbase ^ (unsigned)(c * 32)) + ks * 8192));
    const s16x4 hi = __builtin_amdgcn_ds_read_tr16_b64_v4i16((LAS s16x4*)(tile + (tbase ^ (unsigned)(c * 32 + 16)) + ks * 8192 + 1024));
    return (bf16x8){lo[0], lo[1], lo[2], lo[3], hi[0], hi[1], hi[2], hi[3]};
}
__device__ __forceinline__ bf16x8 trfrag_p(LAS const unsigned char* tile, unsigned pbase, int c, int sp) {
    const s16x4 lo = __builtin_amdgcn_ds_read_tr16_b64_v4i16((LAS s16x4*)(tile + (pbase ^ (unsigned)(c * 32)) + sp * 8192));
    const s16x4 hi = __builtin_amdgcn_ds_read_tr16_b64_v4i16((LAS s16x4*)(tile + (pbase ^ (unsigned)(c * 32)) + sp * 8192 + 4096));
    return (bf16x8){lo[0], lo[1], lo[2], lo[3], hi[0], hi[1], hi[2], hi[3]};
}
__device__ __forceinline__ void load_tile(const bf16_t* __restrict__ src, size_t ld, LAS unsigned char* tile, int tid) {
#pragma unroll
    for (int i = 0; i < 4; ++i) { const int q = tid + 512 * i, row = q >> 4, ch = q & 15;
        const u32x4 v = *(const u32x4*)(src + (size_t)row * ld + ch * 8);
        *(LAS u32x4*)(tile + off_b(row, ch)) = v; }
}

__device__ __forceinline__ void kv_tiles_request(const bf16_t* __restrict__ U, int n, int h, int tid, u32x4 (&pre)[8]) {
    asm volatile("" : "+v"(tid));
    const bf16_t* ub = U + (size_t)n * 128 * DIN + h * 128 + 5120;
    const unsigned row0 = tid >> 4, ch8 = (tid & 15) * 8;
#pragma unroll
    for (int i = 0; i < 4; ++i) { const unsigned uo = (row0 + 32 * i) * DIN + ch8; pre[i] = *(const u32x4*)(ub + uo); pre[4 + i] = *(const u32x4*)(ub + uo + 1024); }
}
__device__ __forceinline__ void kv_unit(const bf16_t* __restrict__ U, bf16_t* __restrict__ KV, int n, int h, float l2f, float l2b, LAS unsigned char* lds, int tid, int lane, int wave,
                                        u32x4 (&pre)[8], bool has_next, int n2, int h2) {
    asm volatile("" : "+v"(tid)); lane = tid & 63;
    LAS unsigned char* Kf = lds, *Kb = lds + 32768, *Vt = lds + 65536;
#pragma unroll
    for (int i = 0; i < 4; ++i) { const int q = tid + 512 * i, row = q >> 4, ch = q & 15;
        const u32x4 kv = pre[i];
        const u32x4 vv = pre[4 + i];
        const float wf = fexp2(l2f * (float)(127 - row)), wb = fexp2(l2b * (float)row);
        u32x4 a, b;
        a.x = cvt_pk(bflo(kv.x) * wf, bfhi(kv.x) * wf); a.y = cvt_pk(bflo(kv.y) * wf, bfhi(kv.y) * wf); a.z = cvt_pk(bflo(kv.z) * wf, bfhi(kv.z) * wf); a.w = cvt_pk(bflo(kv.w) * wf, bfhi(kv.w) * wf);
        b.x = cvt_pk(bflo(kv.x) * wb, bfhi(kv.x) * wb); b.y = cvt_pk(bflo(kv.y) * wb, bfhi(kv.y) * wb); b.z = cvt_pk(bflo(kv.z) * wb, bfhi(kv.z) * wb); b.w = cvt_pk(bflo(kv.w) * wb, bfhi(kv.w) * wb);
        const unsigned o = off_b(row, ch);
        *(LAS u32x4*)(Kf + o) = a; *(LAS u32x4*)(Kb + o) = b; *(LAS u32x4*)(Vt + o) = vv; }
    __builtin_amdgcn_sched_barrier(0);
    if (has_next) kv_tiles_request(U, n2, h2, tid, pre);
    __builtin_amdgcn_sched_barrier(0);
    __syncthreads();
    f32x4 accf[8], accb[8];
#pragma unroll
    for (int c = 0; c < 8; ++c) { accf[c] = (f32x4){0.f, 0.f, 0.f, 0.f}; accb[c] = (f32x4){0.f, 0.f, 0.f, 0.f}; }
    const int g = lane >> 4; const unsigned tb = tbase_of(lane);
#pragma unroll
    for (int ks = 0; ks < 4; ++ks) {
        const bf16x8 af = trfrag(Kf, tb, wave, ks), ab = trfrag(Kb, tb, wave, ks);
#pragma unroll
        for (int c = 0; c < 8; ++c) { const bf16x8 bv = trfrag(Vt, tb, c, ks);
            accf[c] = __builtin_amdgcn_mfma_f32_16x16x32_bf16(bv, af, accf[c], 0, 0, 0);
            accb[c] = __builtin_amdgcn_mfma_f32_16x16x32_bf16(bv, ab, accb[c], 0, 0, 0); }
    }
    bf16_t* of = KV + (size_t)((n * NH + h) * 2 + 0) * 16384 + (16 * wave + (lane & 15)) * 128 + 4 * g;
    bf16_t* ob = of + 16384;
#pragma unroll
#define KV_PK(lo, hi) ((((__float_as_uint(lo) + 0x7fffu + ((__float_as_uint(lo) >> 16) & 1u)) >> 16)) | (((__float_as_uint(hi) + 0x7fffu + ((__float_as_uint(hi) >> 16) & 1u)) >> 16) << 16))
    for (int c = 0; c < 8; ++c) { u32x2 wf_, wb_; wf_.x = KV_PK(accf[c][0], accf[c][1]); wf_.y = KV_PK(accf[c][2], accf[c][3]); wb_.x = KV_PK(accb[c][0], accb[c][1]); wb_.y = KV_PK(accb[c][2], accb[c][3]);
        *(u32x2*)(of + 16 * c) = wf_; *(u32x2*)(ob + 16 * c) = wb_; }
    __syncthreads();
}

__device__ __forceinline__ void load8(const bf16_t* p, float (&d)[8]) { const u32x4 v = *(const u32x4*)p; d[0] = bflo(v.x); d[1] = bfhi(v.x); d[2] = bflo(v.y); d[3] = bfhi(v.y); d[4] = bflo(v.z); d[5] = bfhi(v.z); d[6] = bflo(v.w); d[7] = bfhi(v.w); }
__device__ __forceinline__ void conv_run(const bf16_t* __restrict__ U, bf16_t* __restrict__ CAT, LAS const float* wt  , int t0, int s0, int s1, int lane) {
    asm volatile("" : "+v"(lane));
    const bf16_t* ub = U + 8 * lane;
    const u32x4 zero4 = (u32x4){0u, 0u, 0u, 0u};
#define RAW_LOAD(dst, t) do { const bool in_ = ((t) + 1 >= s0 && (t) + 1 < s1); const size_t rg_ = (size_t)(in_ ? (t) + 1 : (t)) * DIN; const size_t rt_ = (size_t)(t) * DIN; \
        dst[0] = *(const u32x4*)(ub + rg_); dst[1] = *(const u32x4*)(ub + rg_ + 512); dst[2] = *(const u32x4*)(ub + rg_ + 2048); dst[3] = *(const u32x4*)(ub + rg_ + 2048 + 512); \
        dst[4] = *(const u32x4*)(ub + rt_ + 1024); dst[5] = *(const u32x4*)(ub + rt_ + 1024 + 512); dst[6] = *(const u32x4*)(ub + rt_ + 3072); dst[7] = *(const u32x4*)(ub + rt_ + 3072 + 512); \
        if (!in_) { dst[0] = zero4; dst[1] = zero4; dst[2] = zero4; dst[3] = zero4; } } while (0)
#define UNPK(v, d) do { d[0] = bflo(v.x); d[1] = bfhi(v.x); d[2] = bflo(v.y); d[3] = bfhi(v.y); d[4] = bflo(v.z); d[5] = bfhi(v.z); d[6] = bflo(v.w); d[7] = bfhi(v.w); } while (0)
    u32x4 pre[4], cur[8];
    { const bool in_ = (t0 - 1 >= s0); const size_t r_ = (size_t)(in_ ? t0 - 1 : t0) * DIN;
      pre[0] = *(const u32x4*)(ub + r_); pre[1] = *(const u32x4*)(ub + r_ + 512); pre[2] = *(const u32x4*)(ub + r_ + 2048); pre[3] = *(const u32x4*)(ub + r_ + 2048 + 512);
      if (!in_) { pre[0] = zero4; pre[1] = zero4; pre[2] = zero4; pre[3] = zero4; } }
    u32x4 g0[4];
    { const size_t r_ = (size_t)t0 * DIN; g0[0] = *(const u32x4*)(ub + r_); g0[1] = *(const u32x4*)(ub + r_ + 512); g0[2] = *(const u32x4*)(ub + r_ + 2048); g0[3] = *(const u32x4*)(ub + r_ + 2048 + 512); }
    RAW_LOAD(cur, t0);
    __builtin_amdgcn_sched_barrier(0);
    float gp[16], gc[16], gn[16];
#define LDW(d, off) do { const f32x4 a_ = *(LAS const f32x4*)(wt + (off)), b_ = *(LAS const f32x4*)(wt + (off) + 4); d[0] = a_[0]; d[1] = a_[1]; d[2] = a_[2]; d[3] = a_[3]; d[4] = b_[0]; d[5] = b_[1]; d[6] = b_[2]; d[7] = b_[3]; } while (0)
#pragma unroll
    for (int jj = 0; jj < 2; ++jj) { float hh[8], cc[8]; UNPK(pre[jj], hh); UNPK(pre[2 + jj], cc);
#pragma unroll
        for (int e = 0; e < 8; ++e) gp[jj * 8 + e] = hh[e] * cc[e];
        UNPK(g0[jj], hh); UNPK(g0[2 + jj], cc);
#pragma unroll
        for (int e = 0; e < 8; ++e) gc[jj * 8 + e] = hh[e] * cc[e]; }
#pragma unroll
    for (int tt = 0; tt < 4; ++tt) {
        const int t = t0 + tt;
        float y[16]; float ss = 0.f;
#pragma unroll
        for (int jj = 0; jj < 2; ++jj) { float hh[8], cc[8], bb[8], a0[8], a1[8], a2[8]; UNPK(cur[jj], hh); UNPK(cur[2 + jj], cc); UNPK(cur[4 + jj], bb);
            const int cb = 8 * lane + 512 * jj; LDW(a0, cb); LDW(a1, 1024 + cb); LDW(a2, 2048 + cb);
#pragma unroll
            for (int e = 0; e < 8; ++e) { const int i = jj * 8 + e; gn[i] = hh[e] * cc[e]; y[i] = bb[e] * (a0[e] * gp[i] + a1[e] * gc[i] + a2[e] * gn[i]); ss += y[i] * y[i]; } }
        const u32x4 z0 = cur[6], z1 = cur[7];
        __builtin_amdgcn_sched_barrier(0);
        if (tt < 3) RAW_LOAD(cur, t + 1);
        __builtin_amdgcn_sched_barrier(0);
        const float rstd = frsq(wave_sum(ss) * (1.f / DCONV) + EPS);
#pragma unroll
        for (int jj = 0; jj < 2; ++jj) { float zz[8], an[8]; if (jj == 0) UNPK(z0, zz); else UNPK(z1, zz); LDW(an, 3072 + 8 * lane + 512 * jj); float o[8];
#pragma unroll
            for (int e = 0; e < 8; ++e) { const int i = jj * 8 + e; o[e] = silu_f(zz[e]) * (y[i] * rstd * an[e]); }
            u32x4 w; w.x = cvt_pk(o[0], o[1]); w.y = cvt_pk(o[2], o[3]); w.z = cvt_pk(o[4], o[5]); w.w = cvt_pk(o[6], o[7]);
            *(u32x4*)(CAT + (size_t)t * D + 8 * lane + 512 * jj) = w; }
#pragma unroll
        for (int e = 0; e < 16; ++e) { gp[e] = gc[e]; gc[e] = gn[e]; }
        __builtin_amdgcn_sched_barrier(0);
    }
#undef RAW_LOAD
#undef UNPK
#undef LDW
}

__device__ __forceinline__ void conv_fix_row(const bf16_t* __restrict__ U, bf16_t* __restrict__ CAT, const float* __restrict__ cw, const float* __restrict__ cnw, int t, int s0, int s1, int lane) {
    asm volatile("" : "+v"(lane));
    const int cb = 64 * (lane >> 2) + 16 * (lane & 3), ub = 256 * (lane >> 2) + 32 * (lane & 3);
    const u32x4 z4 = (u32x4){0u, 0u, 0u, 0u};
    u32x4 rp[4], rc[4], rn[4], rb[4];
    const bool hp = (t - 1 >= s0), hn = (t + 1 < s1);
#pragma unroll
    for (int fq = 0; fq < 4; ++fq) {
        rp[fq] = *(const u32x4*)(U + (size_t)(hp ? t - 1 : t) * DIN + ub + 8 * fq);
        rc[fq] = *(const u32x4*)(U + (size_t)t * DIN + ub + 8 * fq);
        rn[fq] = *(const u32x4*)(U + (size_t)(hn ? t + 1 : t) * DIN + ub + 8 * fq);
        rb[fq] = *(const u32x4*)(U + (size_t)t * DIN + ub + 128 + 8 * fq);
        if (!hp) rp[fq] = z4; if (!hn) rn[fq] = z4; }
    float y[16], zz[16]; float ss = 0.f;
#pragma unroll
    for (int fq = 0; fq < 4; ++fq) {
        const f32x4 w0 = *(const f32x4*)(cw + cb + 4 * fq), w1 = *(const f32x4*)(cw + 1024 + cb + 4 * fq), w2 = *(const f32x4*)(cw + 2048 + cb + 4 * fq);
#define GV(v, j) ((j) == 0 ? bflo(v.x) * bflo(v.z) : (j) == 1 ? bfhi(v.x) * bfhi(v.z) : (j) == 2 ? bflo(v.y) * bflo(v.w) : bfhi(v.y) * bfhi(v.w))
#pragma unroll
        for (int j = 0; j < 4; ++j) { const float gp = GV(rp[fq], j), gc = GV(rc[fq], j), gn = GV(rn[fq], j);
            const float b = (j == 0) ? bflo(rb[fq].x) : (j == 1) ? bfhi(rb[fq].x) : (j == 2) ? bflo(rb[fq].y) : bfhi(rb[fq].y);
            zz[4 * fq + j] = (j == 0) ? bflo(rb[fq].z) : (j == 1) ? bfhi(rb[fq].z) : (j == 2) ? bflo(rb[fq].w) : bfhi(rb[fq].w);
            const float yy = b * (w0[j] * gp + w1[j] * gc + w2[j] * gn); y[4 * fq + j] = yy; ss += yy * yy; }
#undef GV
    }
    const float rstd = frsq(wave_sum(ss) * (1.f / DCONV) + EPS);
#pragma unroll
    for (int hh = 0; hh < 2; ++hh) { float o[8];
#pragma unroll
        for (int e = 0; e < 8; ++e) { const int i = 8 * hh + e; o[e] = silu_f(zz[i]) * (y[i] * rstd * cnw[cb + i]); }
        u32x4 w; w.x = cvt_pk(o[0], o[1]); w.y = cvt_pk(o[2], o[3]); w.z = cvt_pk(o[4], o[5]); w.w = cvt_pk(o[6], o[7]);
        *(u32x4*)(CAT + (size_t)t * D + cb + 8 * hh) = w; }
}
__device__ __forceinline__ void conv_finish_rows(const bf16_t* __restrict__ U, bf16_t* __restrict__ CAT, const float* __restrict__ rowsq, const float* __restrict__ cw, const float* __restrict__ cnw, int t0, int lane) {
    asm volatile("" : "+v"(lane));
    u32x4 v[4][2]; float rs[4];
#pragma unroll
    for (int k = 0; k < 4; ++k) { const int t = t0 + k; v[k][0] = __builtin_nontemporal_load((const u32x4*)(CAT + (size_t)t * D + 16 * lane)); v[k][1] = __builtin_nontemporal_load((const u32x4*)(CAT + (size_t)t * D + 16 * lane + 8)); rs[k] = rowsq[t]; }
    __builtin_amdgcn_sched_barrier(0);
#pragma unroll
    for (int k = 0; k < 4; ++k) { const int t = t0 + k; const int r63 = t & 63;
        if (r63 == 0 || r63 == 63) continue;
        const float rstd = frsq(rs[k] * (1.f / DCONV) + EPS);
#pragma unroll
        for (int hh = 0; hh < 2; ++hh) { const u32x4 a = v[k][hh]; u32x4 w;
            w.x = cvt_pk(bflo(a.x) * rstd, bfhi(a.x) * rstd); w.y = cvt_pk(bflo(a.y) * rstd, bfhi(a.y) * rstd); w.z = cvt_pk(bflo(a.z) * rstd, bfhi(a.z) * rstd); w.w = cvt_pk(bflo(a.w) * rstd, bfhi(a.w) * rstd);
            *(u32x4*)(CAT + (size_t)t * D + 16 * lane + 8 * hh) = w; } }
#pragma unroll
    for (int k = 0; k < 4; ++k) { const int t = t0 + k; const int r63 = t & 63;
        if (r63 == 0 || r63 == 63) conv_fix_row(U, CAT, cw, cnw, t, 0, SEQ, lane); }
}

__device__ __forceinline__ void scan_phase(const bf16_t* __restrict__ KV, bf16_t* __restrict__ SP, const float* __restrict__ dec_f, const float* __restrict__ dec_b, int tid) {
    asm volatile("" : "+v"(tid));
    const int G = gridDim.x;
    for (int T = blockIdx.x * NTHREADS + tid; T < 16 * 8192; T += G * NTHREADS) {
        const int hd = T >> 13, e2 = T & 8191, h = hd >> 1, dir = hd & 1;
        const float lg = -expf(dir ? dec_b[h] : dec_f[h]);
        const float cd = fexp2(lg * LOG2E * 128.f);
        const size_t base = (size_t)(h * 2 + dir) * 16384 + 2 * e2;
        float s0 = 0.f, s1 = 0.f;
        const long cstride = (long)NH * 2 * 16384;
        const int c0 = dir ? 65 : 64, c1 = dir ? 64 : 65;
        const unsigned a0 = __builtin_nontemporal_load((const unsigned*)(KV + (size_t)c0 * cstride + base)), a1 = __builtin_nontemporal_load((const unsigned*)(KV + (size_t)c1 * cstride + base));
        const long step = dir ? -cstride : cstride;
        const bf16_t* kp = KV + (size_t)(dir ? 63 : 0) * cstride + base;
        bf16_t* sp = SP + (size_t)(dir ? 63 : 0) * cstride + base;
        unsigned cur[16], nxt[16];
#pragma unroll
        for (int j = 0; j < 16; ++j) cur[j] = __builtin_nontemporal_load((const unsigned*)(kp + j * step));
        *(unsigned*)(SP + (size_t)c0 * cstride + base) = 0u;
        s0 = bflo(a0); s1 = bfhi(a0);
        *(unsigned*)(SP + (size_t)c1 * cstride + base) = cvt_pk(s0, s1);
        s0 = cd * s0 + bflo(a1); s1 = cd * s1 + bfhi(a1);
#pragma unroll 1
        for (int b = 0; b < 4; ++b) {
            const long nb = (b < 3) ? 16 * step : 0;
#pragma unroll
            for (int j = 0; j < 16; ++j) nxt[j] = __builtin_nontemporal_load((const unsigned*)(kp + nb + j * step));
            __builtin_amdgcn_sched_barrier(0);
#pragma unroll
            for (int j = 0; j < 16; ++j) { *(unsigned*)(sp + j * step) = cvt_pk(s0, s1); s0 = cd * s0 + bflo(cur[j]); s1 = cd * s1 + bfhi(cur[j]); }
            __builtin_amdgcn_sched_barrier(0);
            kp += 16 * step; sp += 16 * step;
#pragma unroll
            for (int j = 0; j < 16; ++j) cur[j] = nxt[j];
        }
    }
}

__device__ __forceinline__ void ret_tiles_request(const bf16_t* __restrict__ U, int n, int h, int tid, u32x4 (&pre)[12]) {
    asm volatile("" : "+v"(tid));
    const bf16_t* ub = U + (size_t)n * 128 * DIN + h * 128 + 4096;
    const unsigned row0 = tid >> 4, ch8 = (tid & 15) * 8;
#pragma unroll
    for (int i = 0; i < 4; ++i) { const unsigned uo = (row0 + 32 * i) * DIN + ch8; pre[i] = __builtin_nontemporal_load((const u32x4*)(ub + uo)); pre[4 + i] = __builtin_nontemporal_load((const u32x4*)(ub + uo + 1024)); pre[8 + i] = __builtin_nontemporal_load((const u32x4*)(ub + uo + 2048)); }
}
template <int VAR>
__device__ __forceinline__ void ret_unit(const bf16_t* __restrict__ U, const bf16_t* __restrict__ SP, bf16_t* __restrict__ CAT, const float* __restrict__ gnw, int n, int h, float l2f, float l2b,
                                         LAS unsigned char* lds, int tid, int lane, int wave, u32x4 (&pre)[12], bool has_next, int n2, int h2) {
    asm volatile("" : "+v"(tid));
    LAS unsigned char* Qt = lds, *Kt = lds + 32768, *Vt = lds + 65536, *St = lds + 98304;
    const size_t r0 = (size_t)n * 128;
    const bf16_t* spf = SP + (size_t)((n * NH + h) * 2) * 16384;
#pragma unroll
    for (int i = 0; i < 4; ++i) { const int q = tid + 512 * i; const unsigned o = off_b(q >> 4, q & 15); *(LAS u32x4*)(Qt + o) = pre[i]; *(LAS u32x4*)(Kt + o) = pre[4 + i]; *(LAS u32x4*)(Vt + o) = pre[8 + i]; }
    asm volatile("" : "+v"(lane));
    u32x4 sfr[4], sbr[4]; unsigned zr[16];
#pragma unroll
    for (int i = 0; i < 4; ++i) { const int q = tid + 512 * i, row = q >> 4, ch = q & 15;
        sfr[i] = __builtin_nontemporal_load((const u32x4*)(spf + (size_t)row * 128 + ch * 8));
        sbr[i] = __builtin_nontemporal_load((const u32x4*)(spf + 16384 + (size_t)row * 128 + ch * 8)); }
    __builtin_amdgcn_sched_barrier(0);
    __syncthreads();
    const int g = lane >> 4, li = lane & 15; const unsigned rb_ = rbase_of(lane), tb = tbase_of(lane), pb = pbase_of(lane);
    bf16x8 qf[4];
#pragma unroll
    for (int s = 0; s < 4; ++s) qf[s] = rowfrag(Qt, rb_, wave, s);
    bf16x8 pf[4];
#pragma unroll
    for (int sp = 0; sp < 4; ++sp) {
        f32x4 sa = (f32x4){0.f, 0.f, 0.f, 0.f}, sb = (f32x4){0.f, 0.f, 0.f, 0.f};
#pragma unroll
        for (int s = 0; s < 4; ++s) { sa = __builtin_amdgcn_mfma_f32_16x16x32_bf16(rowfrag(Kt, rb_, 2 * sp, s), qf[s], sa, 0, 0, 0);
                                      sb = __builtin_amdgcn_mfma_f32_16x16x32_bf16(rowfrag(Kt, rb_, 2 * sp + 1, s), qf[s], sb, 0, 0, 0); }
        const int i = 16 * wave + li;
        float pa[4], pb2[4];
#pragma unroll
        for (int r = 0; r < 4; ++r) {
            const int ja = 32 * sp + 4 * g + r, jb = ja + 16;
            const int da = i - ja, db = i - jb;
            const float ea = fexp2((da > 0 ? l2f : l2b) * (float)(da < 0 ? -da : da)), eb = fexp2((db > 0 ? l2f : l2b) * (float)(db < 0 ? -db : db));
            const float ma = (da == 0) ? 2.f : ea, mb = (db == 0) ? 2.f : eb;
            pa[r] = sa[r] * ma; pb2[r] = sb[r] * mb; }
        const unsigned w0 = cvt_pk(pa[0], pa[1]), w1 = cvt_pk(pa[2], pa[3]), w2 = cvt_pk(pb2[0], pb2[1]), w3 = cvt_pk(pb2[2], pb2[3]);
        const u32x4 w = (u32x4){w0, w1, w2, w3};
        pf[sp] = __builtin_bit_cast(bf16x8, w);
        __builtin_amdgcn_sched_barrier(0);
    }
    f32x4 accO[8], accF[8];
#pragma unroll
    for (int c = 0; c < 8; ++c) { accO[c] = (f32x4){0.f, 0.f, 0.f, 0.f}; accF[c] = (f32x4){0.f, 0.f, 0.f, 0.f}; }
#pragma unroll
    for (int sp = 0; sp < 4; ++sp) {
#pragma unroll
        for (int c = 0; c < 8; ++c) accO[c] = __builtin_amdgcn_mfma_f32_16x16x32_bf16(pf[sp], trfrag_p(Vt, pb, c, sp), accO[c], 0, 0, 0);
        __builtin_amdgcn_sched_barrier(0); }
    { const bf16_t* zp = U + (r0 + 16 * wave) * DIN + 7168 + h * 128 + 2 * lane;
#pragma unroll
      for (int rr = 0; rr < 16; ++rr) zr[rr] = __builtin_nontemporal_load((const unsigned*)(zp + (size_t)rr * DIN)); }
    __builtin_amdgcn_sched_barrier(0);
    __syncthreads();
#pragma unroll
    for (int i = 0; i < 4; ++i) { const int q = tid + 512 * i; const unsigned o = off_b(q >> 4, q & 15); *(LAS u32x4*)(St + o) = sfr[i]; *(LAS u32x4*)(Qt + o) = sbr[i]; }
    __syncthreads();
    float qdf[4], qdb[4];
#pragma unroll
    for (int r = 0; r < 4; ++r) { const int i = 16 * wave + 4 * g + r; qdf[r] = fexp2(l2f * (float)(i + 1)); qdb[r] = fexp2(l2b * (float)(128 - i)); }
#pragma unroll
    for (int s = 0; s < 4; ++s) {
#pragma unroll
        for (int c = 0; c < 8; ++c) accF[c] = __builtin_amdgcn_mfma_f32_16x16x32_bf16(qf[s], trfrag(St, tb, c, s), accF[c], 0, 0, 0);
        __builtin_amdgcn_sched_barrier(0); }
#pragma unroll
    for (int c = 0; c < 8; ++c)
#pragma unroll
        for (int r = 0; r < 4; ++r) accO[c][r] += qdf[r] * accF[c][r];
#pragma unroll
    for (int c = 0; c < 8; ++c) accF[c] = (f32x4){0.f, 0.f, 0.f, 0.f};
#pragma unroll
    for (int s = 0; s < 4; ++s) {
#pragma unroll
        for (int c = 0; c < 8; ++c) accF[c] = __builtin_amdgcn_mfma_f32_16x16x32_bf16(qf[s], trfrag(Qt, tb, c, s), accF[c], 0, 0, 0);
        __builtin_amdgcn_sched_barrier(0); }
#pragma unroll
    for (int c = 0; c < 8; ++c)
#pragma unroll
        for (int r = 0; r < 4; ++r) accO[c][r] += qdb[r] * accF[c][r];
    LAS float* stg = (LAS float*)(lds + 32768 + wave * 8192);
#pragma unroll
    for (int r = 0; r < 4; ++r) {
        float s = 0.f;
#pragma unroll
        for (int c = 0; c < 8; ++c) s += accO[c][r];
#pragma unroll
        for (int o = 1; o < 16; o <<= 1) s += __shfl_xor(s, o);
        const float mu = s * (1.f / 128.f);
        float v = 0.f;
#pragma unroll
        for (int c = 0; c < 8; ++c) { const float d = accO[c][r] - mu; v += d * d; }
#pragma unroll
        for (int o = 1; o < 16; o <<= 1) v += __shfl_xor(v, o);
        const float rstd = frsq(v * (1.f / 128.f) + EPS);
#pragma unroll
        for (int c = 0; c < 8; ++c) stg[(4 * g + r) * 128 + 16 * c + li] = (accO[c][r] - mu) * rstd;
    }
    LDS_WAIT();
    __builtin_amdgcn_sched_barrier(0);
    if (has_next) ret_tiles_request(U, n2, h2, tid, pre);
    __builtin_amdgcn_sched_barrier(0);
    { const float gn0 = gnw[h * 128 + 2 * lane], gn1 = gnw[h * 128 + 2 * lane + 1];
      bf16_t* op = CAT + (r0 + 16 * wave) * D + 1024 + h * 128 + 2 * lane;
#pragma unroll
      for (int rr = 0; rr < 16; ++rr) {
          const float v0 = stg[rr * 128 + 2 * lane], v1 = stg[rr * 128 + 2 * lane + 1];
          const unsigned z = zr[rr];
          *(unsigned*)(op + (size_t)rr * D) = cvt_pk(silu_f(bflo(z)) * v0 * gn0, silu_f(bfhi(z)) * v1 * gn1); } }
    __syncthreads();
}

template <int MI, int NI, int MODE>
__device__ __forceinline__ void small_gemm(const bf16_t* __restrict__ A, const bf16_t* __restrict__ WT, int m0, int n0, int lane,
                                           bf16_t* __restrict__ Uc, const float* __restrict__ resid, const float* __restrict__ gate, float* __restrict__ Xc) {
    asm volatile("" : "+v"(lane));
    const int li = lane & 15, g = lane >> 4;
    const bf16_t* ap = A + (size_t)(m0 + li) * 2048 + 8 * g;
    const bf16_t* bp = WT + (size_t)(n0 + li) * 2048 + 8 * g;
    f32x4 acc[MI][NI];
#pragma unroll
    for (int mi = 0; mi < MI; ++mi)
#pragma unroll
        for (int ni = 0; ni < NI; ++ni) acc[mi][ni] = (f32x4){0.f, 0.f, 0.f, 0.f};
    bf16x8 fa[2][8][MI], fb[2][8][NI];
#define SG_LOAD(buf, kb) do { _Pragma("unroll") for (int j = 0; j < 8; ++j) { _Pragma("unroll") for (int mi = 0; mi < MI; ++mi) fa[buf][j][mi] = *(const bf16x8*)(ap + (size_t)mi * 16 * 2048 + ((kb) * 8 + j) * 32); \
        _Pragma("unroll") for (int ni = 0; ni < NI; ++ni) fb[buf][j][ni] = *(const bf16x8*)(bp + (size_t)ni * 16 * 2048 + ((kb) * 8 + j) * 32); } } while (0)
    SG_LOAD(0, 0);
#pragma unroll
    for (int kb = 0; kb < 8; ++kb) {
        if (kb + 1 < 8) { if (kb & 1) SG_LOAD(0, kb + 1); else SG_LOAD(1, kb + 1); }
        __builtin_amdgcn_sched_barrier(0);
#pragma unroll
        for (int j = 0; j < 8; ++j)
#pragma unroll
            for (int mi = 0; mi < MI; ++mi)
#pragma unroll
                for (int ni = 0; ni < NI; ++ni) acc[mi][ni] = __builtin_amdgcn_mfma_f32_16x16x32_bf16(fb[kb & 1][j][ni], fa[kb & 1][j][mi], acc[mi][ni], 0, 0, 0);
        __builtin_amdgcn_sched_barrier(0);
    }
#undef SG_LOAD
    int gq = g; asm volatile("" : "+v"(gq));
#pragma unroll
    for (int mi = 0; mi < MI; ++mi)
#pragma unroll
        for (int ni = 0; ni < NI; ++ni) {
            const int row = m0 + 16 * mi + li, col = n0 + 16 * ni + 4 * gq;
            if (MODE == 0) { const float sc = (col >= 5120 && col < 6144) ? 0.08838834764831845f : 1.f; const f32x4 v = acc[mi][ni] * sc;
                u32x2 w; w.x = cvt_pk(v[0], v[1]); w.y = cvt_pk(v[2], v[3]); *(u32x2*)(Uc + (size_t)row * DIN + col) = w; }
            else { const f32x4 r = *(const f32x4*)(resid + (size_t)row * D + col), gt = *(const f32x4*)(gate + col); *(f32x4*)(Xc + (size_t)row * D + col) = r + gt * acc[mi][ni]; }
        }
}

constexpr int SLAB_PITCH = 4112;
template <int NI, int MODE>
__device__ __forceinline__ void ctx_gemm_slab(const bf16_t* __restrict__ A, const bf16_t* __restrict__ WT, int m0, int n0, int tid, int wave, LAS unsigned char* lds,
                                              bf16_t* __restrict__ Uc, const float* __restrict__ resid, const float* __restrict__ gate, float* __restrict__ Xc) {
    asm volatile("" : "+v"(tid));
    const int lane = tid & 63, li = lane & 15, g = lane >> 4;
    { u32x4 t[16];
#pragma unroll
      for (int i = 0; i < 16; ++i) { const int q = tid + 512 * i; t[i] = *(const u32x4*)(A + (size_t)(m0 + (q >> 8)) * 2048 + (q & 255) * 8); }
#pragma unroll
      for (int i = 0; i < 16; ++i) { const int q = tid + 512 * i; *(LAS u32x4*)(lds + (q >> 8) * SLAB_PITCH + (q & 255) * 16) = t[i]; } }
    __syncthreads();
    const int nw0 = n0 + 16 * NI * wave;
    const bf16_t* bp = WT + (size_t)(nw0 + li) * 2048 + 8 * g;
    LAS const unsigned char* ap = lds + li * SLAB_PITCH + 16 * g;
    f32x4 acc[2][NI];
#pragma unroll
    for (int mi = 0; mi < 2; ++mi)
#pragma unroll
        for (int ni = 0; ni < NI; ++ni) acc[mi][ni] = (f32x4){0.f, 0.f, 0.f, 0.f};
    constexpr int KB = (NI == 1) ? 16 : 8, NB = 64 / KB;
    bf16x8 fb[2][KB][NI];
#define SL_LOAD(buf, kb) do { _Pragma("unroll") for (int j = 0; j < KB; ++j) { _Pragma("unroll") for (int ni = 0; ni < NI; ++ni) fb[buf][j][ni] = *(const bf16x8*)(bp + (size_t)ni * 16 * 2048 + ((kb) * KB + j) * 32); } } while (0)
    SL_LOAD(0, 0);
#pragma unroll
    for (int kb = 0; kb < NB; ++kb) {
        if (kb + 1 < NB) { if (kb & 1) SL_LOAD(0, kb + 1); else SL_LOAD(1, kb + 1); }
        __builtin_amdgcn_sched_barrier(0);
#pragma unroll
        for (int j = 0; j < KB; ++j) {
            bf16x8 a[2];
#pragma unroll
            for (int mi = 0; mi < 2; ++mi) a[mi] = *(LAS const bf16x8*)(ap + mi * 16 * SLAB_PITCH + (kb * KB + j) * 64);
#pragma unroll
            for (int mi = 0; mi < 2; ++mi)
#pragma unroll
                for (int ni = 0; ni < NI; ++ni) acc[mi][ni] = __builtin_amdgcn_mfma_f32_16x16x32_bf16(fb[kb & 1][j][ni], a[mi], acc[mi][ni], 0, 0, 0);
        }
        __builtin_amdgcn_sched_barrier(0);
    }
#undef SL_LOAD
    int gq = g; asm volatile("" : "+v"(gq));
#pragma unroll
    for (int mi = 0; mi < 2; ++mi)
#pragma unroll
        for (int ni = 0; ni < NI; ++ni) {
            const int row = m0 + 16 * mi + li, col = nw0 + 16 * ni + 4 * gq;
            if (MODE == 0) { const float sc = (col >= 5120 && col < 6144) ? 0.08838834764831845f : 1.f; const f32x4 v = acc[mi][ni] * sc;
                u32x2 w; w.x = cvt_pk(v[0], v[1]); w.y = cvt_pk(v[2], v[3]); *(u32x2*)(Uc + (size_t)row * DIN + col) = w; }
            else { const f32x4 r = *(const f32x4*)(resid + (size_t)row * D + col), gt = *(const f32x4*)(gate + col); *(f32x4*)(Xc + (size_t)row * D + col) = r + gt * acc[mi][ni]; }
        }
    __syncthreads();
}

#define XB_TMO      128
#define XB_XCNT(j)  (256  + 64 * (j))
#define XB_XSUB(j)  (1280 + 64 * (j))
#define XB_XGEN(j)  (2304 + 64 * (j))
#define XB_TOP      3328
#define XB_TOPGEN   3392
#define XCD_BAR_WORDS 3456
#define XB_SPIN_CAP (1u << 18)

__device__ __forceinline__ unsigned xb_ld(unsigned* p)              { return __hip_atomic_load(p, __ATOMIC_RELAXED, __HIP_MEMORY_SCOPE_AGENT); }
__device__ __forceinline__ unsigned xb_add(unsigned* p, unsigned v) { return __hip_atomic_fetch_add(p, v, __ATOMIC_RELAXED, __HIP_MEMORY_SCOPE_AGENT); }
__device__ __forceinline__ unsigned xb_xcc_id() { return (unsigned)__builtin_amdgcn_s_getreg((3 << 11) | 20) & 0xFu; }
#define XB_SPIN(cond, bar) do { unsigned _sp = 0; while (cond) { __builtin_amdgcn_s_sleep(1); \
    if ((++_sp & 255u) == 0u) { if (xb_ld(&(bar)[XB_TMO])) break; if (_sp > XB_SPIN_CAP) { atomicAdd(&(bar)[XB_TMO], 1u); break; } } } } while (0)

struct XcdBarrier {
    unsigned* bar; unsigned x;
    volatile LAS unsigned* st;
};

__device__ __forceinline__ XcdBarrier xcd_barrier_post(unsigned* bar, volatile LAS unsigned* st) {
    XcdBarrier b; b.bar = bar; b.x = xb_xcc_id(); b.st = st;
    if (threadIdx.x == 0) (void)xb_add(&bar[XB_XCNT(b.x)], 1u);
    return b;
}
__device__ __forceinline__ void xcd_barrier_complete(unsigned* bar, unsigned x, unsigned& nloc, unsigned& nx) {
    const unsigned G = gridDim.x * gridDim.y * gridDim.z;
    unsigned sum, cnt, mine, sp = 0u;
    for (;;) {
        sum = 0u; cnt = 0u; mine = 0u;
#pragma unroll
        for (unsigned j = 0; j < 16; ++j) { const unsigned c = xb_ld(&bar[XB_XCNT(j)]); sum += c; cnt += (c > 0u) ? 1u : 0u; mine = (j == x) ? c : mine; }
        if (sum == G) break;
        __builtin_amdgcn_s_sleep(1);
        if ((++sp & 255u) == 0u) { if (xb_ld(&bar[XB_TMO])) break; if (sp > XB_SPIN_CAP) { atomicAdd(&bar[XB_TMO], 1u); break; } }
    }
    nloc = mine > 0u ? mine : 1u; nx = cnt > 0u ? cnt : 1u;
}

__device__ __forceinline__ void xcd_barrier(const XcdBarrier& b) {
    asm volatile("s_waitcnt vmcnt(0)" ::: "memory");
    __syncthreads();
    if (threadIdx.x == 0) {
        unsigned* bar = b.bar; const unsigned bx_ = xb_xcc_id();
        __builtin_amdgcn_s_waitcnt(0);
        unsigned nloc = b.st[0], nx = b.st[1];
        if (nloc == 0u) { xcd_barrier_complete(bar, bx_, nloc, nx); b.st[0] = nloc; b.st[1] = nx; }
        const unsigned old = xb_add(&bar[XB_XSUB(bx_)], 1u);
        const unsigned gen = old / nloc;
        if (old + 1u == (gen + 1u) * nloc) {
            __builtin_amdgcn_fence(__ATOMIC_RELEASE, "agent");
            asm volatile("s_waitcnt vmcnt(0)" ::: "memory");
            const unsigned og = xb_add(&bar[XB_TOP], 1u);
            const unsigned tg = og / nx;
            if (og + 1u == (tg + 1u) * nx) xb_add(&bar[XB_TOPGEN], 1u);
            else XB_SPIN(xb_ld(&bar[XB_TOPGEN]) == tg, bar);
            __builtin_amdgcn_fence(__ATOMIC_ACQUIRE, "agent");
            xb_add(&bar[XB_XGEN(bx_)], 1u);
            asm volatile("s_waitcnt vmcnt(0)" ::: "memory");
        } else {
            XB_SPIN(xb_ld(&bar[XB_XGEN(bx_)]) == gen, bar);
            __builtin_amdgcn_fence(__ATOMIC_ACQUIRE, "agent");
            asm volatile("s_waitcnt vmcnt(0)" ::: "memory");
        }
    }
    __syncthreads();
}


__global__ void __launch_bounds__(NTHREADS, 2) fwd_megakernel(Args A) {
    extern __shared__ __attribute__((aligned(16))) unsigned char lds_raw[];
    LAS unsigned char* lds = (LAS unsigned char*)lds_raw;
    cg::grid_group grid = cg::this_grid();
    const int tid = threadIdx.x, lane = tid & 63, wave = __builtin_amdgcn_readfirstlane(tid >> 6);
    const int G = gridDim.x, bx = blockIdx.x, gw = bx * NWAVES + wave, NGW = G * NWAVES;
    unsigned char* ws = A.ws;
    const float* modacc = (const float*)(ws + WS_MODACC);
    bf16_t* HX = (bf16_t*)(ws + WS_HX); bf16_t* U = (bf16_t*)(ws + WS_U); bf16_t* CAT = (bf16_t*)(ws + WS_CAT);
    float* X1 = (float*)(ws + WS_X1); bf16_t* KV = (bf16_t*)(ws + WS_KV); bf16_t* SP = (bf16_t*)(ws + WS_SP);
    volatile LAS unsigned* MISC = (volatile LAS unsigned*)(lds + LDS_BYTES - 256);
    if (tid < 32) MISC[tid] = 0u;
    __syncthreads();
    XcdBarrier xbar = xcd_barrier_post((unsigned*)(ws + WS_CTL), MISC + 8);
#define GRID_BAR() do { xcd_barrier(xbar); } while (0)

#if PH & 1
    phase0(A, lds, tid, lane, wave);
#endif
    if (A.ws == nullptr) grid.sync();
    GRID_BAR();

    for (int l = 0; l < 2; ++l) {
        const float* modx = modacc + (size_t)(l * 2 + 0) * 6144;
        const float* modc = modacc + (size_t)(l * 2 + 1) * 6144;
#if PH & 2
        for (int ra2 = 0; ra2 < REP_A; ++ra2) { if (ra2) GRID_BAR(); const float* nw = A.in[4] + l * D;
          const float* sx = (l == 0) ? A.in[0] : X1;
          const float* sc = (l == 0) ? A.in[2] : X1 + (size_t)SEQ * D;
          norm_mod_rows(sx, SEQ, HX, nw, modx, modx + D, gw, NGW, lane);
          norm_mod_rows(sc, CTXL, HX + (size_t)SEQ * D, nw, modc, modc + D, gw, NGW, lane); }
#endif
        GRID_BAR();
#if PH & 4
        for (int rep_b = 0; rep_b < REP_B; ++rep_b) { const bf16_t* WinT = (const bf16_t*)(ws + WS_WIN) + (size_t)l * 8192 * 2048;
          pg8::Gemm g{HX, WinT, SEQ, DIN, D}; pg8::StaticOrder S; S.init(SEQ, DIN, G, bx);
          pg8::EpiIn E{U, (const float*)(ws + WS_ROPE), A.in[8] + l * 3 * DCONV, A.in[9] + l * DCONV, rep_b ? (bf16_t*)(ws + WS_KV) : CAT, rep_b ? (float*)(ws + WS_SP) : (float*)(ws + WS_ROWSQ) + l * SEQ};
          pg8::gemm_phase<pg8::EpiIn, pg8::StaticOrder, true, true>(lds, g, S, E);
          const int vb = bx & 255;
          (void)vb;
          if (l == 0) { for (int t = bx; t < 256; t += G) ctx_gemm_slab<2, 0>(HX + (size_t)SEQ * D, WinT, (t & 7) * 32, (t >> 3) * 256, tid, wave, lds, U + (size_t)SEQ * DIN, nullptr, nullptr, nullptr); }
          else { for (int t = bx; t < 128; t += G) ctx_gemm_slab<1, 0>(HX + (size_t)SEQ * D, WinT, (t & 7) * 32, 5120 + (t >> 3) * 128, tid, wave, lds, U + (size_t)SEQ * DIN, nullptr, nullptr, nullptr); }
          if (rep_b + 1 < REP_B) GRID_BAR(); }
#endif
        GRID_BAR();
        for (int rep_c = 0; rep_c < REP_CDE; ++rep_c) {
#if PH & 8
        for (int rc2 = 0; rc2 < REP_C; ++rc2) { const int nrows = (l == 0) ? MROWS : SEQ;
          { u32x4 kpre[8];
            { const int u0 = bx < NCH * NH ? bx : NCH * NH - 1; kv_tiles_request(U, u0 >> 3, u0 & 7, tid, kpre); }
            const bool same_h = (G & 7) == 0; const int h0 = bx & 7;
            const float l2f0 = -expf(A.in[11][l * NH + h0]) * LOG2E, l2b0 = -expf(A.in[12][l * NH + h0]) * LOG2E;
            for (int u = bx; u < NCH * NH; u += G) { const int n = u >> 3, h = u & 7; const int u2 = u + G;
                const float l2f = same_h ? l2f0 : -expf(A.in[11][l * NH + h]) * LOG2E, l2b = same_h ? l2b0 : -expf(A.in[12][l * NH + h]) * LOG2E;
                kv_unit(U, KV, n, h, l2f, l2b, lds, tid, lane, wave, kpre, u2 < NCH * NH, u2 >> 3, u2 & 7); } }
          { const float* cw = A.in[8] + l * 3 * DCONV; const float* cnw = A.in[9] + l * DCONV; const float* rowsq = (const float*)(ws + WS_ROWSQ) + l * SEQ;
            for (int t0 = 4 * gw; t0 < SEQ; t0 += 4 * NGW) conv_finish_rows(U, CAT, rowsq, cw, cnw, t0, lane);
            if (l == 0) { for (int t = NGW - 1 - gw; t < CTXL; t += NGW) conv_fix_row(U, CAT, cw, cnw, SEQ + t, SEQ, MROWS, lane); }
            if (l == 0) { __syncthreads(); if (G > 16) { if (bx >= 16) mod_gemv(A, lds, 1, bx - 16, G - 16, tid, lane, wave); } else mod_gemv(A, lds, 1, bx, G, tid, lane, wave);
                          if (G > 128 && bx >= 16) convert_weights(A, lds, 1, 0, L1C_A, (bx - 16) * NWAVES + wave, (G - 16) * NWAVES, lane, wave); } }
          if (rc2 + 1 < REP_C) GRID_BAR(); }
#endif
        GRID_BAR();
#if PH & 16
        for (int rd2 = 0; rd2 < REP_D; ++rd2) { if (rd2) GRID_BAR();
        scan_phase(KV, SP, A.in[11] + l * NH, A.in[12] + l * NH, tid); }
#endif
        u32x4 pre[12];
        { const int nchq = (l == 0) ? NCH : 64; const int u0 = bx < nchq * NH ? bx : nchq * NH - 1; ret_tiles_request(U, u0 >> 3, u0 & 7, tid, pre); }
        GRID_BAR();
#if PH & 32
        for (int re2 = 0; re2 < REP_E; ++re2) { const int nch = (l == 0) ? NCH : 64;
          if (re2) { GRID_BAR(); const int u0 = bx < nch * NH ? bx : nch * NH - 1; ret_tiles_request(U, u0 >> 3, u0 & 7, tid, pre); }
          const bool same_h = (G & 7) == 0; const int h0 = bx & 7;
          const float l2f0 = -expf(A.in[11][l * NH + h0]) * LOG2E, l2b0 = -expf(A.in[12][l * NH + h0]) * LOG2E;
          for (int u = bx; u < nch * NH; u += G) { const int n = u >> 3, h = u & 7; const int u2 = u + G; const bool hn = u2 < nch * NH;
              const float l2f = same_h ? l2f0 : -expf(A.in[11][l * NH + h]) * LOG2E, l2b = same_h ? l2b0 : -expf(A.in[12][l * NH + h]) * LOG2E;
              ret_unit<0>(U, SP, CAT, A.in[10] + l * 1024, n, h, l2f, l2b, lds, tid, lane, wave, pre, hn, u2 >> 3, u2 & 7); }
          if (l == 0) { if (G > 128) { if (bx >= 16) convert_weights(A, lds, 1, L1C_A, L1C_B, (bx - 16) * NWAVES + wave, (G - 16) * NWAVES, lane, wave); } else convert_weights(A, lds, 1, 0, 10240, bx * NWAVES + wave, G * NWAVES, lane, wave); } }
#endif
        GRID_BAR();
        }
#if PH & 64
        for (int rf2 = 0; rf2 < (l == 0 ? REP_F0 : 1); ++rf2) { if (rf2) GRID_BAR(); const bf16_t* WoT = (const bf16_t*)(ws + WS_WOUT) + (size_t)l * 2048 * 2048;
          pg8::Gemm g{CAT, WoT, SEQ, D, D}; pg8::StaticOrder S; S.init(SEQ, D, G, bx);
          pg8::EpiRes E{(l == 0) ? A.in[0] : X1, X1, X1, modx + 2 * D, modc + 2 * D};
          pg8::gemm_phase<pg8::EpiRes, pg8::StaticOrder, true, true>(lds, g, S, E);
          if (l == 0 && G > 128 && bx >= 128) convert_weights(A, lds, 1, L1C_B, 10240, (bx - 128) * NWAVES + wave, (G - 128) * NWAVES, lane, wave);
          if (l == 0) { for (int t = bx; t < 128; t += G) ctx_gemm_slab<1, 1>(CAT + (size_t)SEQ * D, WoT, (t & 7) * 32, (t >> 3) * 128, tid, wave, lds, nullptr, A.in[2], modc + 2 * D, X1 + (size_t)SEQ * D); } }
#endif
        GRID_BAR();
    }
#ifdef REP_BAR
    for (int rb9 = 0; rb9 < REP_BAR; ++rb9) GRID_BAR();
#endif
#if PH & 128
    final_norm_rows(X1, SEQ, A.out, A.in[14], gw, NGW, lane);
#endif
}

extern "C" void kernel_launch(void* const* d_in, const int* in_sizes, int n_in, void* d_out, int out_size, void* d_ws, size_t ws_size, hipStream_t stream) {
    static int grid = 0;
    if (grid == 0) {
        if (n_in != 15 || ws_size < WS_END) { fprintf(stderr, "kernel_launch: unexpected n_in %d / ws %zu\n", n_in, ws_size); grid = -1; return; }
        int dev = 0, cus = 0, per_cu = 0;
        hipGetDevice(&dev);
        hipDeviceGetAttribute(&cus, hipDeviceAttributeMultiprocessorCount, dev);
        hipFuncSetAttribute((const void*)fwd_megakernel, hipFuncAttributeMaxDynamicSharedMemorySize, LDS_BYTES);
        hipOccupancyMaxActiveBlocksPerMultiprocessor(&per_cu, (const void*)fwd_megakernel, NTHREADS, LDS_BYTES);
        if (per_cu < 1) { fprintf(stderr, "kernel_launch: occupancy query says %d blocks per CU\n", per_cu); per_cu = 1; }
        grid = cus;
        if (grid > 256) grid = 256;
    }
    if (grid < 0) return;
    hipMemsetAsync((char*)d_ws + WS_CTL, 0, CTL_ZERO_BYTES, stream);
    Args a{};
    for (int i = 0; i < 15; ++i) a.in[i] = (const float*)d_in[i];
    a.out = (float*)d_out; a.ws = (unsigned char*)d_ws;
    void* args[] = {&a};
    hipError_t e = hipLaunchCooperativeKernel((const void*)fwd_megakernel, dim3(grid), dim3(NTHREADS), args, LDS_BYTES, stream);
    if (e != hipSuccess) fprintf(stderr, "cooperative launch failed: %s (grid %d)\n", hipGetErrorString(e), grid);
}
```
